# Optimizing an MI355X kernel written in HIP

```python
import math
import jax, jax.numpy as jnp
from jax import lax
import numpy as np

D_MODEL = 1024
BATCH = 4
SEQ = 4096
DEPTH = 2

GRID_W = 64
CTX_LEN = 256
N_MIXERS = 4
D_MIX = D_MODEL
GROUP_W = D_MIX // N_MIXERS
M_HEADS = 4
M_HD = GROUP_W // M_HEADS
M_CHUNK = 64
M_GATES = 2 * 2 * M_HEADS
A_HEADS = 4
A_HD = GROUP_W // (2 * A_HEADS)
N_FREQ = A_HD // 4
ROPE_THETA = 10000.0
Q_BLOCK = 128
POOL_WINDOWS = (2, 4, 8, 16)
POOL_GW = GROUP_W // len(POOL_WINDOWS)
CONV_K = 31
FF_RAW = -(-8 * D_MODEL // 3)
D_FF = -(-FF_RAW // 256) * 256
IN_SPLITS = (GROUP_W, GROUP_W, GROUP_W, GROUP_W, M_GATES, GROUP_W, GROUP_W, GROUP_W, GROUP_W, 2 * GROUP_W)
IN_COLS = sum(IN_SPLITS)

kernel_name = "hybrid_parallel_group_flow_block"


def rms_norm(x, g, eps=1e-6):
    xf = x.astype(jnp.float32)
    y = xf * lax.rsqrt(jnp.mean(xf * xf, axis=-1, keepdims=True) + eps)
    return (y * g).astype(x.dtype)


def layer_norm(x, g, b, eps=1e-5):
    xf = x.astype(jnp.float32)
    mu = jnp.mean(xf, axis=-1, keepdims=True)
    var = jnp.mean(jnp.square(xf - mu), axis=-1, keepdims=True)
    return ((xf - mu) * lax.rsqrt(var + eps) * g + b).astype(x.dtype)


def modulate(x, shift, scale):
    return x * (1 + scale) + shift


def split_columns(p):
    idx, acc = [], 0
    for s in IN_SPLITS[:-1]:
        acc += s
        idx.append(acc)
    return jnp.split(p, idx, axis=-1)


def flip(a):
    return jnp.flip(a, axis=1)


def axial_rope_tables(n_tokens):
    n_rows = n_tokens // GRID_W
    rows = jnp.repeat(jnp.arange(n_rows), GRID_W).astype(jnp.float32)
    cols = jnp.tile(jnp.arange(GRID_W), n_rows).astype(jnp.float32)
    freqs = ROPE_THETA ** (-jnp.arange(N_FREQ, dtype=jnp.float32) / N_FREQ)
    ang = jnp.stack([rows[:, None] * freqs, cols[:, None] * freqs], axis=1)
    return jnp.cos(ang), jnp.sin(ang)


def apply_axial_rope(x, cos, sin):
    shp = x.shape
    xr = x.reshape(shp[:-1] + (2, 2, N_FREQ))
    x0, x1 = xr[..., 0, :], xr[..., 1, :]
    c = cos[None, :, None, None].astype(x.dtype)
    s = sin[None, :, None, None].astype(x.dtype)
    out = jnp.stack([x0 * c - x1 * s, x1 * c + x0 * s], axis=-2)
    return out.reshape(shp)


def mlstm_inputs(mq, mk, mv, mg, gate_b):
    B, L, _ = mq.shape
    q = mq.reshape(B, L, M_HEADS, M_HD).astype(jnp.float32)
    k = mk.reshape(B, L, M_HEADS, M_HD).astype(jnp.float32) * (M_HD ** -0.5)
    v = mv.reshape(B, L, M_HEADS, M_HD).astype(jnp.float32)
    gates = mg.reshape(B, L, 2, 2, M_HEADS).astype(jnp.float32) + gate_b
    log_i = gates[:, :, :, 0]
    log_f = jax.nn.log_sigmoid(gates[:, :, :, 1])
    return q, k, v, log_i, log_f


def mlstm_scan(q, k, v, log_i, log_f, state):
    B, L, H, d = q.shape
    nc = L // M_CHUNK

    def to_chunks(a):
        return jnp.moveaxis(a.reshape((B, nc, M_CHUNK) + a.shape[2:]), 1, 0)

    causal = jnp.tril(jnp.ones((M_CHUNK, M_CHUNK), dtype=bool))[None, :, :, None]

    def step(carry, inp):
        C, n, m = carry
        qc, kc, vc, ic, fc = inp
        b = jnp.cumsum(fc, axis=1)
        b_tot = b[:, -1]
        inter = b + m[:, None]
        log_d = b[:, :, None, :] - b[:, None, :, :] + ic[:, None, :, :]
        log_d = jnp.where(causal, log_d, -jnp.inf)
        m_t = jnp.maximum(inter, jnp.max(log_d, axis=2))
        sw = jnp.exp(log_d - m_t[:, :, None, :]) * jnp.einsum('bthd,bshd->btsh', qc, kc)
        e_inter = jnp.exp(inter - m_t)
        num = e_inter[..., None] * jnp.einsum('bhvk,bthk->bthv', C, qc) + jnp.einsum('btsh,bshv->bthv', sw, vc)
        den = e_inter * jnp.einsum('bhk,bthk->bth', n, qc) + jnp.sum(sw, axis=2)
        h = num / jnp.maximum(jnp.abs(den), jnp.exp(-m_t))[..., None]
        g = b_tot[:, None] - b + ic
        m_new = jnp.maximum(b_tot + m, jnp.max(g, axis=1))
        e_old = jnp.exp(b_tot + m - m_new)
        e_s = jnp.exp(g - m_new[:, None])
        C_new = e_old[..., None, None] * C + jnp.einsum('bsh,bshv,bshk->bhvk', e_s, vc, kc)
        n_new = e_old[..., None] * n + jnp.einsum('bsh,bshk->bhk', e_s, kc)
        return (C_new, n_new, m_new), h

    final, hs = lax.scan(step, state, (to_chunks(q), to_chunks(k), to_chunks(v), to_chunks(log_i), to_chunks(log_f)))
    return jnp.moveaxis(hs, 0, 1).reshape(B, L, H, d), final


def mlstm_out(h, o_pre, norm_g):
    B, L = o_pre.shape[:2]
    o = jax.nn.sigmoid(o_pre.reshape(B, L, M_HEADS, M_HD).astype(jnp.float32))
    return (o * rms_norm(h, norm_g)).reshape(B, L, GROUP_W).astype(o_pre.dtype)


def attn_inputs(aq, ak, av, q_norm_g, k_norm_g, rope):
    B, L, _ = aq.shape
    q = rms_norm(aq.reshape(B, L, A_HEADS, 2, A_HD), q_norm_g)
    k = rms_norm(ak.reshape(B, L, A_HEADS, 2, A_HD), k_norm_g)
    v = av.reshape(B, L, A_HEADS, 2 * A_HD)
    if rope is not None:
        q = apply_axial_rope(q, rope[0], rope[1])
        k = apply_axial_rope(k, rope[0], rope[1])
    return q, k, v


def diff_softmax_attend(q, k, v, lam):
    s = jnp.einsum('bqhmd,bkhmd->bhmqk', q, k).astype(jnp.float32) * (A_HD ** -0.5)
    p = jax.nn.softmax(s, axis=-1)
    a = p[:, :, 0] - lam * p[:, :, 1]
    return jnp.einsum('bhqk,bkhe->bqhe', a.astype(v.dtype), v)


def blocked_latent_attention(q, k_all, v_all, lam):
    B, L = q.shape[:2]
    nb = L // Q_BLOCK
    qb = jnp.moveaxis(q.reshape((B, nb, Q_BLOCK) + q.shape[2:]), 1, 0)
    ob = lax.map(lambda qq: diff_softmax_attend(qq, k_all, v_all, lam), qb)
    return jnp.moveaxis(ob, 0, 1).reshape((B, L) + ob.shape[3:])


def attn_out(o, subln_g, lam_init):
    B, L = o.shape[:2]
    return (rms_norm(o, subln_g) * (1 - lam_init)).reshape(B, L, GROUP_W)


def multiscale_pool(u):
    B, L, _ = u.shape
    uf = u.astype(jnp.float32)
    cs = jnp.concatenate([jnp.zeros((B, 1, GROUP_W), jnp.float32), jnp.cumsum(uf, axis=1)], axis=1)
    t = jnp.arange(L)
    outs = []
    for gi, w in enumerate(POOL_WINDOWS):
        lo = jnp.clip(t - w // 2, 0, L - 1)
        hi = jnp.clip(t + (w - 1 - w // 2), 0, L - 1)
        csg = cs[:, :, gi * POOL_GW:(gi + 1) * POOL_GW]
        mean = (csg[:, hi + 1] - csg[:, lo]) / (hi - lo + 1).astype(jnp.float32)[None, :, None]
        outs.append(mean - uf[:, :, gi * POOL_GW:(gi + 1) * POOL_GW])
    return jnp.concatenate(outs, axis=-1).astype(u.dtype)


def pool_branch(u, pool_w, pool_scale):
    B, L, _ = u.shape
    y = multiscale_pool(u).reshape(B, L, len(POOL_WINDOWS), POOL_GW)
    y = jnp.einsum('blgc,gcd->blgd', y, pool_w).reshape(B, L, GROUP_W)
    return y * pool_scale


def conformer_conv(u, dw_w, dw_b, ln_g, ln_b, pw_w):
    a, g = jnp.split(u, 2, axis=-1)
    y = a * jax.nn.sigmoid(g)
    y = lax.conv_general_dilated(y, dw_w[:, None, :], window_strides=(1,),
                                 padding=((CONV_K // 2, CONV_K // 2),),
                                 dimension_numbers=('NWC', 'WIO', 'NWC'),
                                 feature_group_count=GROUP_W) + dw_b
    y = jax.nn.silu(layer_norm(y, ln_g, ln_b))
    return y @ pw_w


def swiglu(u, w_in, w_out):
    g, up = jnp.split(u @ w_in, 2, axis=-1)
    return (jax.nn.silu(g) * up) @ w_out


def hybrid_mixer(u_lat, u_ctx, rope, w_in, gate_b, m_norm_g, q_norm_g, k_norm_g, lam_q, lam_k, subln_g,
                 pool_w, pool_scale, dw_w, dw_b, ln_g, ln_b, pw_w, lam_init, need_ctx):
    pl = split_columns(u_lat @ w_in)
    pc = split_columns(u_ctx @ w_in)
    B = u_lat.shape[0]
    ql, kl, vl, il, fl = mlstm_inputs(pl[0], pl[1], pl[2], pl[4], gate_b)
    qc, kc, vc, ic, fc = mlstm_inputs(pc[0], pc[1], pc[2], pc[4], gate_b)
    zero = (jnp.zeros((B, M_HEADS, M_HD, M_HD), jnp.float32),
            jnp.zeros((B, M_HEADS, M_HD), jnp.float32),
            jnp.zeros((B, M_HEADS), jnp.float32))
    hcf, st_f = mlstm_scan(qc, kc, vc, ic[:, :, 0], fc[:, :, 0], zero)
    hcb, st_b = mlstm_scan(flip(qc), flip(kc), flip(vc), flip(ic[:, :, 1]), flip(fc[:, :, 1]), zero)
    hlf, _ = mlstm_scan(ql, kl, vl, il[:, :, 0], fl[:, :, 0], st_f)
    hlb, _ = mlstm_scan(flip(ql), flip(kl), flip(vl), flip(il[:, :, 1]), flip(fl[:, :, 1]), st_b)
    m_lat = mlstm_out(hlf + flip(hlb), pl[3], m_norm_g)
    lam = (jnp.exp(jnp.sum(lam_q[0] * lam_k[0])) - jnp.exp(jnp.sum(lam_q[1] * lam_k[1])) + lam_init).astype(jnp.float32)
    aql, akl, avl = attn_inputs(pl[5], pl[6], pl[7], q_norm_g, k_norm_g, rope)
    aqc, akc, avc = attn_inputs(pc[5], pc[6], pc[7], q_norm_g, k_norm_g, None)
    k_all = jnp.concatenate([akc, akl], axis=1)
    v_all = jnp.concatenate([avc, avl], axis=1)
    a_lat = attn_out(blocked_latent_attention(aql, k_all, v_all, lam), subln_g, lam_init)
    p_lat = pool_branch(pl[8], pool_w, pool_scale)
    c_lat = conformer_conv(pl[9], dw_w, dw_b, ln_g, ln_b, pw_w)
    y_lat = jnp.concatenate([m_lat, a_lat, p_lat, c_lat], axis=-1)
    if not need_ctx:
        return y_lat, None
    m_ctx = mlstm_out(hcf + flip(hcb), pc[3], m_norm_g)
    a_ctx = attn_out(diff_softmax_attend(aqc, akc, avc, lam), subln_g, lam_init)
    p_ctx = pool_branch(pc[8], pool_w, pool_scale)
    c_ctx_out = conformer_conv(pc[9], dw_w, dw_b, ln_g, ln_b, pw_w)
    y_ctx = jnp.concatenate([m_ctx, a_ctx, p_ctx, c_ctx_out], axis=-1)
    return y_lat, y_ctx


def setup_inputs(seed: int = 0) -> dict:
    key = jax.random.key(seed)
    ks = iter(jax.random.split(key, 32))
    nrm = lambda shape, s: jax.random.normal(next(ks), shape, jnp.float32) * s
    gate_b = jnp.stack([nrm((DEPTH, 2, M_HEADS), 0.1),
                        3.0 + 3.0 * jax.random.uniform(next(ks), (DEPTH, 2, M_HEADS), jnp.float32)], axis=2)
    return {
        "x": nrm((BATCH, SEQ, D_MODEL), 1.0),
        "c": nrm((BATCH, D_MODEL), 1.0),
        "ctx": nrm((BATCH, CTX_LEN, D_MODEL), 1.0),
        "c_ctx": nrm((D_MODEL,), 1.0),
        "norm1_g": 1.0 + nrm((DEPTH, D_MODEL), 0.02),
        "norm2_g": 1.0 + nrm((DEPTH, D_MODEL), 0.02),
        "mod_w": nrm((DEPTH, D_MODEL, 6 * D_MODEL), D_MODEL ** -0.5),
        "mod_b": nrm((DEPTH, 6 * D_MODEL), 0.02),
        "w_in": nrm((DEPTH, D_MODEL, IN_COLS), D_MODEL ** -0.5),
        "mlstm_gate_b": gate_b,
        "mlstm_norm_g": 1.0 + nrm((DEPTH, M_HD), 0.02),
        "attn_q_norm_g": 1.0 + nrm((DEPTH, A_HD), 0.02),
        "attn_k_norm_g": 1.0 + nrm((DEPTH, A_HD), 0.02),
        "lambda_q": nrm((DEPTH, 2, A_HD), 0.1),
        "lambda_k": nrm((DEPTH, 2, A_HD), 0.1),
        "attn_subln_g": 1.0 + nrm((DEPTH, 2 * A_HD), 0.02),
        "pool_w": nrm((DEPTH, len(POOL_WINDOWS), POOL_GW, POOL_GW), POOL_GW ** -0.5),
        "pool_scale": 1.0 + nrm((DEPTH, GROUP_W), 0.1),
        "conv_dw_w": nrm((DEPTH, CONV_K, GROUP_W), CONV_K ** -0.5),
        "conv_dw_b": nrm((DEPTH, GROUP_W), 0.02),
        "conv_ln_g": 1.0 + nrm((DEPTH, GROUP_W), 0.02),
        "conv_ln_b": nrm((DEPTH, GROUP_W), 0.02),
        "conv_pw_w": nrm((DEPTH, GROUP_W, GROUP_W), GROUP_W ** -0.5),
        "w_out": nrm((DEPTH, D_MIX, D_MODEL), D_MIX ** -0.5),
        "ffn_w_in": nrm((DEPTH, D_MODEL, 2 * D_FF), D_MODEL ** -0.5),
        "ffn_w_out": nrm((DEPTH, D_FF, D_MODEL), D_FF ** -0.5),
    }


def reference(x, c, ctx, c_ctx, norm1_g, norm2_g, mod_w, mod_b, w_in, mlstm_gate_b, mlstm_norm_g,
              attn_q_norm_g, attn_k_norm_g, lambda_q, lambda_k, attn_subln_g, pool_w, pool_scale,
              conv_dw_w, conv_dw_b, conv_ln_g, conv_ln_b, conv_pw_w, w_out, ffn_w_in, ffn_w_out):
    L = x.shape[1]
    rope = axial_rope_tables(L)
    h, hc = x, ctx
    s_c = jax.nn.silu(c)
    s_cc = jax.nn.silu(c_ctx)
    for l in range(DEPTH):
        need_ctx = l < DEPTH - 1
        lam_init = 0.8 - 0.6 * math.exp(-0.3 * l)
        mod_lat = (s_c @ mod_w[l] + mod_b[l])[:, None, :]
        mod_ctx = (s_cc @ mod_w[l] + mod_b[l])[None, None, :]
        sh1, sc1, g1, sh2, sc2, g2 = jnp.split(mod_lat, 6, axis=-1)
        csh1, csc1, cg1, csh2, csc2, cg2 = jnp.split(mod_ctx, 6, axis=-1)
        u_lat = modulate(rms_norm(h, norm1_g[l]), sh1, sc1)
        u_ctx = modulate(rms_norm(hc, norm1_g[l]), csh1, csc1)
        y_lat, y_ctx = hybrid_mixer(u_lat, u_ctx, rope, w_in[l], mlstm_gate_b[l], mlstm_norm_g[l],
                                    attn_q_norm_g[l], attn_k_norm_g[l], lambda_q[l], lambda_k[l],
                                    attn_subln_g[l], pool_w[l], pool_scale[l], conv_dw_w[l], conv_dw_b[l],
                                    conv_ln_g[l], conv_ln_b[l], conv_pw_w[l], lam_init, need_ctx)
        h = h + g1 * (y_lat @ w_out[l])
        h = h + g2 * swiglu(modulate(rms_norm(h, norm2_g[l]), sh2, sc2), ffn_w_in[l], ffn_w_out[l])
        if need_ctx:
            hc = hc + cg1 * (y_ctx @ w_out[l])
            hc = hc + cg2 * swiglu(modulate(rms_norm(hc, norm2_g[l]), csh2, csc2), ffn_w_in[l], ffn_w_out[l])
    return h
```

```cpp
#include <hip/hip_runtime.h>
#include <hip/hip_cooperative_groups.h>
#include <cstdio>
#include <cstdint>
namespace cg = cooperative_groups;
namespace pg8 {
#define PG8_LAS __attribute__((address_space(3)))
typedef unsigned short bf16_t;
typedef short bf16x8 __attribute__((ext_vector_type(8)));
typedef float f32x4 __attribute__((ext_vector_type(4)));
typedef unsigned u32x4 __attribute__((ext_vector_type(4)));
constexpr int BM = 256, BK = 64, HALF = 128, HTB = HALF * BK * 2  , STAGE_BYTES = 8 * HTB, NXCD = 8, WGM = 8;

__host__ __device__ __forceinline__ int lds_byte(int r, int c) { const int st = (r >> 4) * 2 + (c >> 5), rr = r & 15, cc = c & 31, ob = rr * 64 + cc * 2; return st * 1024 + (ob ^ (((ob >> 9) & 1) << 5)); }
__host__ __device__ __forceinline__ void stage_rc(int b, int& R, int& C) { const int st = b / 1024, sb = b % 1024, swz = sb ^ (((sb >> 9) & 1) << 5); R = (st >> 1) * 16 + swz / 64; C = (st & 1) * 32 + (swz % 64) / 2; }
__host__ __device__ __forceinline__ int perm32(int rho) { const int n = rho >> 4, i = rho & 15; return 8 * (i >> 2) + 4 * n + (i & 3); }

struct Unit { int pm, pn; };
struct Gemm { const bf16_t* A; const bf16_t* Bt; int M, N, K, ld; };

struct StaticOrder {
    int nM, nN, nwg, G, c;
    __host__ __device__ void init(int M, int N, int G_, int c_) { nM = M / BM; nN = N / BM; nwg = nM * nN; G = G_; c = c_; }
    __host__ __device__ bool next(int i, Unit& u) const {
        const long L = (long)i * G + c; if (L >= nwg) return false;
        int wgid = (int)L; { const int q = nwg / NXCD, r = nwg % NXCD, xcd = wgid % NXCD, off = wgid / NXCD; wgid = (xcd < r ? xcd * (q + 1) : r * (q + 1) + (xcd - r) * q) + off; }
        const int nig = WGM * nN, gid = wgid / nig, fm = gid * WGM, gsz = (nM - fm) < WGM ? (nM - fm) : WGM;
        u.pm = fm + ((wgid % nig) % gsz); u.pn = (wgid % nig) / gsz; return true;
    }
    __device__ __forceinline__ void a_ready(const Unit&) const {}
    __device__ __forceinline__ void done(const Unit&) const {}
};

struct SplitOrder {
    int nN, nsplit, ksub, nitems, G, c;
    __host__ __device__ void init(int M, int N, int nsplit_, int ksub_, int G_, int c_) { nN = N / BM; nsplit = nsplit_; ksub = ksub_; nitems = (M / BM) * nN * nsplit_; G = G_; c = c_; }
    __host__ __device__ bool next(int i, Unit& u) const { const int L = i * G + c; if (L >= nitems) return false; const int t = L / nsplit; u.pm = t / nN; u.pn = (t % nN) | ((L % nsplit) << 8); return true; }
    __device__ __forceinline__ void a_ready(const Unit&) const {}
    __device__ __forceinline__ void done(const Unit&) const {}
};
__device__ __forceinline__ unsigned cvt_pk_bf16(float lo, float hi) { unsigned r; asm volatile("v_cvt_pk_bf16_f32 %0, %1, %2" : "=v"(r) : "v"(lo), "v"(hi)); return r; }
template <class Epi, class Sched, bool ALIGN_EPI = false, bool SP2 = false, bool SPLIT = false>
__device__ __forceinline__ void gemm_phase(PG8_LAS unsigned char* lds, const Gemm g, const Sched& S, const Epi& E, const int wave_s) {
    int tid_op; asm volatile("v_mbcnt_lo_u32_b32 %0, -1, 0\n\tv_mbcnt_hi_u32_b32 %0, -1, %0" : "=v"(tid_op)); tid_op += wave_s * 64;
    const int tid = tid_op, wid = __builtin_amdgcn_readfirstlane(tid >> 6), lane = tid & 63, wr = wid >> 2, wc = wid & 3, fr = lane & 15, fq = lane >> 4;
    const int K = g.K, nt = K / BK;
    unsigned voffA[2], voffB[2];
#pragma unroll
    for (int i = 0; i < 2; ++i) { int R, C; stage_rc(tid * 16 + i * 8192, R, C); const int Rb = Epi::PERM ? ((R & ~31) + perm32(R & 31)) : R;
        voffA[i] = (unsigned)(R * (SPLIT ? g.ld : K) + C) * 2u; voffB[i] = (unsigned)(Rb * (SPLIT ? g.ld : K) + C) * 2u; }
    const size_t kstep = (size_t)(BK * 2);
    const size_t hstep = (size_t)HALF * (SPLIT ? g.ld : K) * 2;
    const size_t tstep = 2 * hstep;
    const unsigned ldsw = (unsigned)wid * 1024u;
    const int aoff = lds_byte(wr * 64 + fr, fq * 8), boff = lds_byte(wc * 32 + fr, fq * 8);
#define PG8_SA(b, h) (((b) * 2 + (h)) * HTB)
#define PG8_SB(b, h) ((4 + (b) * 2 + (h)) * HTB)
#define PG8_STAGE(bufoff, gbase, voff) do { _Pragma("unroll") for (int _i = 0; _i < 2; ++_i) \
        __builtin_amdgcn_global_load_lds((const unsigned*)((const char*)(gbase) + (voff)[_i]), (PG8_LAS unsigned*)(lds + (bufoff) + ldsw + _i * 8192), 16, 0, 0); } while (0)
#define PG8_LDA(dst, b, h) do { _Pragma("unroll") for (int m = 0; m < 4; ++m) _Pragma("unroll") for (int k = 0; k < 2; ++k) dst[m][k] = *(const PG8_LAS bf16x8*)(lds + PG8_SA(b, h) + aoff + m * 2048 + k * 1024); } while (0)
#define PG8_LDB(dst, b, h) do { _Pragma("unroll") for (int n = 0; n < 2; ++n) _Pragma("unroll") for (int k = 0; k < 2; ++k) dst[n][k] = *(const PG8_LAS bf16x8*)(lds + PG8_SB(b, h) + boff + n * 2048 + k * 1024); } while (0)
#define PG8_MMA(ai, bj, At, Bt) do { __builtin_amdgcn_s_setprio(1); _Pragma("unroll") for (int m = 0; m < 4; ++m) _Pragma("unroll") for (int n = 0; n < 2; ++n) _Pragma("unroll") for (int k = 0; k < 2; ++k) \
        acc[ai][bj][m][n] = __builtin_amdgcn_mfma_f32_16x16x32_bf16(Bt[n][k], At[m][k], acc[ai][bj][m][n], 0, 0, 0); __builtin_amdgcn_s_setprio(0); } while (0)
#define PG8_WAIT_V(n) asm volatile("s_waitcnt vmcnt(" #n ")" ::: "memory")
#define PG8_WAIT_L(n) asm volatile("s_waitcnt lgkmcnt(" #n ")" ::: "memory")
#define PG8_BAR __builtin_amdgcn_s_barrier()
#define PG8_SCHED __builtin_amdgcn_sched_barrier(0)
    Unit cur, nxt; int ui = 0;
    if (!S.next(0, cur)) return;
    f32x4 acc[2][2][4][2];
#pragma unroll
    for (int a = 0; a < 2; ++a)
#pragma unroll
        for (int b = 0; b < 2; ++b)
#pragma unroll
            for (int m = 0; m < 4; ++m)
#pragma unroll
                for (int n = 0; n < 2; ++n) acc[a][b][m][n] = (f32x4){0.f, 0.f, 0.f, 0.f};
    bf16x8 At[4][2], B0[2][2], B1[2][2];
    const char* cA = (const char*)g.A + (size_t)cur.pm * tstep + (SPLIT ? (size_t)(cur.pn >> 8) * 512 : 0); const char* cB = (const char*)g.Bt + (size_t)(SPLIT ? (cur.pn & 255) : cur.pn) * tstep + (SPLIT ? (size_t)(cur.pn >> 8) * 512 : 0);
    S.a_ready(cur);
    if constexpr (SP2) {
        PG8_STAGE(PG8_SB(0, 0), cB, voffB); PG8_STAGE(PG8_SB(0, 1), cB + hstep, voffB); PG8_STAGE(PG8_SA(0, 0), cA, voffA); PG8_STAGE(PG8_SA(0, 1), cA + hstep, voffA);
        if (wr == 1) PG8_BAR;
        PG8_WAIT_V(2); PG8_BAR;
        PG8_STAGE(PG8_SB(1, 0), cB + kstep, voffB); PG8_STAGE(PG8_SA(1, 0), cA + kstep, voffA); PG8_STAGE(PG8_SB(1, 1), cB + hstep + kstep, voffB);
        PG8_WAIT_V(6); PG8_BAR;
    } else {
        PG8_STAGE(PG8_SB(0, 0), cB, voffB); PG8_STAGE(PG8_SA(0, 0), cA, voffA); PG8_STAGE(PG8_SB(0, 1), cB + hstep, voffB); PG8_STAGE(PG8_SA(0, 1), cA + hstep, voffA);
        if (wr == 1) PG8_BAR;
        PG8_WAIT_V(4); PG8_BAR;
        PG8_STAGE(PG8_SB(1, 0), cB + kstep, voffB); PG8_STAGE(PG8_SA(1, 0), cA + kstep, voffA); PG8_STAGE(PG8_SB(1, 1), cB + hstep + kstep, voffB);
        PG8_WAIT_V(6); PG8_BAR;
    }
    for (;;) {
        const bool has_next = S.next(ui + 1, nxt);
        const char* nA = has_next ? (const char*)g.A + (size_t)nxt.pm * tstep + (SPLIT ? (size_t)(nxt.pn >> 8) * 512 : 0) : cA; const char* nB = has_next ? (const char*)g.Bt + (size_t)(SPLIT ? (nxt.pn & 255) : nxt.pn) * tstep + (SPLIT ? (size_t)(nxt.pn >> 8) * 512 : 0) : cB;
        for (int t = 0; t < nt; t += 2) {
            const bool last = (t == nt - 2);
            const char* a1 = cA + (size_t)(t + 1) * kstep;
            const char* a2 = last ? nA : cA + (size_t)(t + 2) * kstep; const char* b2 = last ? nB : cB + (size_t)(t + 2) * kstep;
            const char* a3 = a2 + kstep; const char* b3 = b2 + kstep;
            if (last && has_next) S.a_ready(nxt);
            if constexpr (SP2) {
            PG8_LDB(B0, 0, 0); PG8_LDB(B1, 0, 1); PG8_SCHED; PG8_LDA(At, 0, 0); PG8_STAGE(PG8_SA(1, 1), a1 + hstep, voffA);
            PG8_WAIT_V(8); PG8_WAIT_L(0); PG8_BAR; PG8_MMA(0, 0, At, B0); PG8_MMA(0, 1, At, B1); PG8_BAR; PG8_SCHED;
            PG8_LDA(At, 0, 1); PG8_STAGE(PG8_SB(0, 0), b2, voffB); PG8_STAGE(PG8_SB(0, 1), b2 + hstep, voffB); PG8_STAGE(PG8_SA(0, 0), a2, voffA);
            PG8_WAIT_V(8); PG8_WAIT_L(0); PG8_BAR; PG8_MMA(1, 0, At, B0); PG8_MMA(1, 1, At, B1); PG8_BAR; PG8_SCHED;
            PG8_LDB(B0, 1, 0); PG8_LDB(B1, 1, 1); PG8_SCHED; PG8_LDA(At, 1, 0); PG8_STAGE(PG8_SA(0, 1), a2 + hstep, voffA);
            PG8_WAIT_V(8); PG8_WAIT_L(0); PG8_BAR; PG8_MMA(0, 0, At, B0); PG8_MMA(0, 1, At, B1); PG8_BAR; PG8_SCHED;
            PG8_LDA(At, 1, 1); PG8_STAGE(PG8_SB(1, 0), b3, voffB); PG8_STAGE(PG8_SB(1, 1), b3 + hstep, voffB); PG8_STAGE(PG8_SA(1, 0), a3, voffA);
            PG8_WAIT_V(8); PG8_WAIT_L(0); PG8_BAR; PG8_MMA(1, 0, At, B0); PG8_MMA(1, 1, At, B1); PG8_BAR; PG8_SCHED;
            } else {
            PG8_LDB(B0, 0, 0); PG8_SCHED; PG8_LDA(At, 0, 0); PG8_STAGE(PG8_SA(1, 1), a1 + hstep, voffA);
            PG8_WAIT_L(8); PG8_BAR; PG8_WAIT_L(0); PG8_MMA(0, 0, At, B0); PG8_BAR; PG8_SCHED;
            PG8_LDB(B1, 0, 1); PG8_STAGE(PG8_SB(0, 0), b2, voffB);
            PG8_BAR; PG8_WAIT_L(0); PG8_MMA(0, 1, At, B1); PG8_BAR;
            PG8_LDA(At, 0, 1); PG8_STAGE(PG8_SA(0, 0), a2, voffA);
            PG8_BAR; PG8_WAIT_L(0); PG8_MMA(1, 0, At, B0); PG8_BAR; PG8_SCHED;
            PG8_STAGE(PG8_SB(0, 1), b2 + hstep, voffB);
            PG8_WAIT_V(6); PG8_BAR; PG8_MMA(1, 1, At, B1); PG8_BAR;
            PG8_LDB(B0, 1, 0); PG8_SCHED; PG8_LDA(At, 1, 0); PG8_STAGE(PG8_SA(0, 1), a2 + hstep, voffA);
            PG8_WAIT_L(8); PG8_BAR; PG8_WAIT_L(0); PG8_MMA(0, 0, At, B0); PG8_BAR; PG8_SCHED;
            PG8_LDB(B1, 1, 1); PG8_STAGE(PG8_SB(1, 0), b3, voffB);
            PG8_BAR; PG8_WAIT_L(0); PG8_MMA(0, 1, At, B1); PG8_BAR;
            PG8_LDA(At, 1, 1); PG8_STAGE(PG8_SA(1, 0), a3, voffA);
            PG8_BAR; PG8_WAIT_L(0); PG8_MMA(1, 0, At, B0); PG8_BAR; PG8_SCHED;
            PG8_STAGE(PG8_SB(1, 1), b3 + hstep, voffB);
            PG8_WAIT_V(6); PG8_BAR; PG8_MMA(1, 1, At, B1); PG8_BAR;
            }
        }
        if constexpr (ALIGN_EPI) { if (wr == 0) PG8_BAR; }
        if constexpr (!Epi::AFTER_DRAIN) { int ln2_; asm volatile("v_mbcnt_lo_u32_b32 %0, -1, 0\n\tv_mbcnt_hi_u32_b32 %0, -1, %0" : "=v"(ln2_)); E(acc, cur, wr, wc, ln2_ & 15, ln2_ >> 4); S.done(cur); }
        if (!has_next) break;
#pragma unroll
        for (int a = 0; a < 2; ++a)
#pragma unroll
            for (int b = 0; b < 2; ++b)
#pragma unroll
                for (int m = 0; m < 4; ++m)
#pragma unroll
                    for (int n = 0; n < 2; ++n) acc[a][b][m][n] = (f32x4){0.f, 0.f, 0.f, 0.f};
        cur = nxt; cA = nA; cB = nB; ++ui;
        if constexpr (ALIGN_EPI) { if (wr == 1) PG8_BAR; }
    }
    PG8_WAIT_V(0);
    if constexpr (!ALIGN_EPI) { if (wr == 0) PG8_BAR; }
    PG8_BAR;
    if constexpr (Epi::AFTER_DRAIN) { E.fused(acc, cur, wr, wc, fr, fq, lds, wid, lane); S.done(cur); }
#undef PG8_SA
#undef PG8_SB
#undef PG8_STAGE
#undef PG8_LDA
#undef PG8_LDB
#undef PG8_MMA
#undef PG8_WAIT_V
#undef PG8_WAIT_L
#undef PG8_BAR
#undef PG8_SCHED
}
}

#ifndef MK_COOP
#define MK_COOP 1
#endif
#ifndef REP_P0
#define REP_P0 1
#endif
#ifndef REP_NORM
#define REP_NORM 1
#endif
#ifndef REP_WIN
#define REP_WIN 1
#endif
#ifndef REP_TILE
#define REP_TILE 1
#endif
#ifndef REP_MLOC
#define REP_MLOC 1
#endif
#ifndef REP_SCAN
#define REP_SCAN 1
#endif
#ifndef REP_ATT
#define REP_ATT 1
#endif
#ifndef REP_MOUT
#define REP_MOUT 1
#endif
#ifndef REP_FIN
#define REP_FIN 1
#endif
#ifndef REP_RES
#define REP_RES 1
#endif
#ifndef REP_SYNC
#define REP_SYNC 1
#endif
#define DI __device__ __forceinline__
#define LAS __attribute__((address_space(3)))
typedef unsigned short bf16_t;
typedef short bf16x8 __attribute__((ext_vector_type(8)));
typedef float f32x4 __attribute__((ext_vector_type(4)));
typedef float f32x16 __attribute__((ext_vector_type(16)));
typedef unsigned u32x4 __attribute__((ext_vector_type(4)));
typedef unsigned u32x2 __attribute__((ext_vector_type(2)));
typedef float f32x2_t __attribute__((ext_vector_type(2)));
typedef __bf16 bf16x2_t __attribute__((ext_vector_type(2)));
#define MFMA32(a, b, c) __builtin_amdgcn_mfma_f32_32x32x16_bf16((a), (b), (c), 0, 0, 0)
#define CFENCE() asm volatile("" ::: "memory")

DI unsigned pk2(float lo, float hi) { f32x2_t v = {lo, hi}; bf16x2_t b = __builtin_convertvector(v, bf16x2_t); return __builtin_bit_cast(unsigned, b); }
DI float bflo(unsigned w) { return __uint_as_float(w << 16); }
DI float bfhi(unsigned w) { return __uint_as_float(w & 0xffff0000u); }
DI float bf2f(bf16_t u) { return __uint_as_float((unsigned)u << 16); }
DI bf16_t f2bf(float f) { return (bf16_t)(pk2(f, 0.f) & 0xffffu); }
DI int crow(int reg, int h) { return (reg & 3) + 8 * (reg >> 2) + 4 * h; }
DI int pi32(int r) { return (r & 0x13) | ((r & 4) << 1) | ((r & 8) >> 1); }
DI float bperm(float v, int src) { return __int_as_float(__builtin_amdgcn_ds_bpermute(src << 2, __float_as_int(v))); }
DI float shx(int lane, float v, int m) { return bperm(v, lane ^ m); }
DI float shu(int lane, float v, int d) { return bperm(v, lane >= d ? lane - d : lane); }
DI float shd(int lane, float v, int d) { return bperm(v, lane + d < 64 ? lane + d : lane); }
DI float wave_sum(int lane, float v) {
#pragma unroll
    for (int o = 1; o < 64; o <<= 1) v += bperm(v, lane ^ o);
    return v;
}
DI float wave_max(int lane, float v) {
#pragma unroll
    for (int o = 1; o < 64; o <<= 1) v = fmaxf(v, bperm(v, lane ^ o));
    return v;
}
DI float sigmoidf_(float x) { return __builtin_amdgcn_rcpf(1.f + __expf(-x)); }
DI float logsigmoidf_(float x) { const float e = __expf(-fabsf(x)); return fminf(x, 0.f) - __logf(1.f + e); }
DI f32x16 zero16() { f32x16 z; for (int i = 0; i < 16; ++i) z[i] = 0.f; return z; }

constexpr int DM = 1024, NBATCH = 4, SEQ = 4096, CTXL = 256, NLAT = NBATCH * SEQ, NCTX = NBATCH * CTXL, NROW = NLAT + NCTX, NPOS = CTXL + SEQ;
constexpr int DFF = 2816, INC = 2576, NWIN = 2816, NCH = NPOS / 64  ;
constexpr size_t MiB = 1u << 20;
constexpr size_t WS_MOD = 0, WS_ROPE = 256 * 1024, WS_CTL = 512 * 1024, CTL_BYTES = 64 * 1024, WS_WIN = 1 * MiB, WS_WOUT = 12 * MiB, WS_FIN = 16 * MiB, WS_FOUT = 38 * MiB, WS_PW = 49 * MiB, WS_POOLW = 49 * MiB + 256 * 1024,
                 WS_HC = 50 * MiB, WS_U = 54 * MiB, WS_GATE = 88 * MiB, WS_CS = 90 * MiB, WS_NS = 107 * MiB, WS_Y = 109 * MiB, WS_PM = 143 * MiB, WS_AQ = 177 * MiB,
                 WS_AK = WS_AQ + 8 * MiB + 512 * 1024, WS_AVT = WS_AK + 8 * MiB + 512 * 1024, WS_PC = WS_AVT + 8 * MiB + 512 * 1024, WS_MKT = 228 * MiB, WS_MVT = WS_MKT + 8 * MiB + 512 * 1024,
                 WS_END = 247 * MiB, WS_HF = WS_Y, WS_CL = WS_U, WS_PART = 203 * MiB, WS_HB2 = 204 * MiB;
static_assert(WS_PC + (size_t)NROW * 768 * 2 <= WS_MKT && WS_MVT + (size_t)16 * 64 * NPOS * 2 <= WS_END && WS_HF + (size_t)NROW * DFF * 2 <= WS_PART && WS_PART + (size_t)11 * NCTX * DM * 4 <= WS_END, "ws map");
constexpr int LDS_BYTES = 135168;

struct Params { const float* in[26]; float* out; unsigned char* ws; int ph_lo, ph_hi; };

struct TrDesc { const float* W; bf16_t* WT; int ldw, col0, K, row0, kb, nb, ncv; };
DI void tr_load(float (&v)[32], const TrDesc& d, int lane) {
    const int k0 = 64 * d.kb, nn = 32 * d.nb + (lane & 31);
#pragma unroll
    for (int i = 0; i < 32; ++i) { const int kk = 2 * i + (lane >> 5); v[i] = nn < d.ncv ? d.W[(size_t)(k0 + kk) * d.ldw + d.col0 + nn] : 0.f; }
}
DI void tr_store(const float (&v)[32], const TrDesc& d, LAS float* scr, int lane) {
    const int k0 = 64 * d.kb, n0 = 32 * d.nb;
#pragma unroll
    for (int i = 0; i < 32; ++i) { const int kk = 2 * i + (lane >> 5); scr[kk * 33 + (lane & 31)] = v[i]; }
    asm volatile("s_waitcnt lgkmcnt(0)" ::: "memory");
    const int c = lane & 7;
#pragma unroll
    for (int jj = 0; jj < 4; ++jj) { const int n = (lane >> 3) + 8 * jj; const LAS float* s = scr + (8 * c) * 33 + n;
        u32x4 o; o.x = pk2(s[0 * 33], s[1 * 33]); o.y = pk2(s[2 * 33], s[3 * 33]); o.z = pk2(s[4 * 33], s[5 * 33]); o.w = pk2(s[6 * 33], s[7 * 33]);
        *(u32x4*)(d.WT + (size_t)(d.row0 + n0 + n) * d.K + k0 + 8 * c) = o; }
    asm volatile("s_waitcnt lgkmcnt(0)" ::: "memory");
}
constexpr int IT_WIN_A = 16 * 32, IT_WIN_B = 16 * 48, IT_WIN_G = 16, IT_WOUT = 16 * 32, IT_FIN = 16 * 176, IT_FOUT = 44 * 32, IT_PW = 4 * 8, IT_POOL = 8;
constexpr int IT_LAYER = IT_WIN_A + IT_WIN_B + IT_WIN_G + IT_WOUT + IT_FIN + IT_FOUT + IT_PW + IT_POOL;

DI const float* pin(const Params& P, int k) { asm volatile("" : "+s"(k)); return (const float*)(__attribute__((address_space(1))) const float*)P.in[k]; }
DI void tr_range(const Params& P, unsigned char* ws, LAS unsigned char* lds, int wave, int lane, int first, int stride, int end) {
    LAS float* scr = (LAS float*)(lds + wave * 16384);
    auto decode = [&](int itg, TrDesc& d) {
        const int l = itg / IT_LAYER; int r = itg % IT_LAYER; d.ncv = 1 << 30;
        const float* w_in = pin(P, 8) + (size_t)l * 1024 * INC; bf16_t* WinT = (bf16_t*)(ws + WS_WIN) + (size_t)l * NWIN * 1024;
        if (r < IT_WIN_A) { d = TrDesc{w_in, WinT, INC, 0, 1024, 0, r / 32, r % 32, 1 << 30}; return; } r -= IT_WIN_A;
        if (r < IT_WIN_B) { d = TrDesc{w_in, WinT, INC, 1040, 1024, 1024, r / 48, r % 48, 1 << 30}; return; } r -= IT_WIN_B;
        if (r < IT_WIN_G) { d = TrDesc{w_in, WinT, INC, 1024, 1024, 2560, r, 0, 16}; return; } r -= IT_WIN_G;
        if (r < IT_WOUT) { d = TrDesc{pin(P, 23) + (size_t)l * 1024 * 1024, (bf16_t*)(ws + WS_WOUT) + (size_t)l * 1024 * 1024, 1024, 0, 1024, 0, r / 32, r % 32, 1 << 30}; return; } r -= IT_WOUT;
        if (r < IT_FIN) { const int kb = r / 176, nbp = r % 176, pn = nbp >> 3, within = nbp & 7, half = within >> 2, q = within & 3;
            d = TrDesc{pin(P, 24) + (size_t)l * 1024 * 2 * DFF, (bf16_t*)(ws + WS_FIN) + (size_t)l * 2 * DFF * 1024, 2 * DFF, half * DFF + 128 * pn + 32 * q, 1024, 256 * pn + 128 * half + 32 * q, kb, 0, 1 << 30}; return; } r -= IT_FIN;
        if (r < IT_FOUT) { d = TrDesc{pin(P, 25) + (size_t)l * DFF * 1024, (bf16_t*)(ws + WS_FOUT) + (size_t)l * 1024 * DFF, 1024, 0, DFF, 0, r / 32, r % 32, 1 << 30}; return; } r -= IT_FOUT;
        if (r < IT_PW) { d = TrDesc{pin(P, 22) + (size_t)l * 256 * 256, (bf16_t*)(ws + WS_PW) + (size_t)l * 256 * 256, 256, 0, 256, 0, r / 8, r % 8, 1 << 30}; return; } r -= IT_PW;
        { const int g = r >> 1; d = TrDesc{pin(P, 16) + (size_t)(l * 4 + g) * 64 * 64, (bf16_t*)(ws + WS_POOLW) + (size_t)(l * 4 + g) * 64 * 64, 64, 0, 64, 0, 0, r & 1, 1 << 30}; }
    };
    {
        float va[32], vb[32]; TrDesc da, db; int it = first; const int total = end, NGW = stride;
        if (it < total) { decode(it, da); tr_load(va, da, lane); }
        while (it < total) {
            int nx = it + NGW; if (nx < total) { decode(nx, db); tr_load(vb, db, lane); }
            tr_store(va, da, scr, lane); it = nx;
            if (it >= total) break;
            nx = it + NGW; if (nx < total) { decode(nx, da); tr_load(va, da, lane); }
            tr_store(vb, db, scr, lane); it = nx;
        }
    }
}

DI void phase0(const Params& P, LAS unsigned char* lds, int tid, int wave, int lane, int G) {
    unsigned char* ws = P.ws;
    const float* c = P.in[1]; const float* cctx = P.in[3]; const float* mod_w = P.in[6]; const float* mod_b = P.in[7];
    float* MOD = (float*)(ws + WS_MOD);
    LAS float* sv = (LAS float*)lds;
    LAS float* red = (LAS float*)(lds + 20480);
    for (int i = tid; i < 5 * 1024; i += 512) { const int j = i >> 10, k = i & 1023; const float v = j < 4 ? c[j * 1024 + k] : cctx[k]; sv[i] = v / (1.f + expf(-v)); }
    __syncthreads();
    for (int it = blockIdx.x; it < 192; it += G) {
        const int l = it / 96, cb = it % 96;
        const float* W = mod_w + (size_t)l * 1024 * 6144 + cb * 64 + lane;
        float a0 = 0.f, a1 = 0.f, a2 = 0.f, a3 = 0.f, a4 = 0.f;
#pragma unroll 32
        for (int kk = 0; kk < 128; ++kk) { const int k = wave * 128 + kk; const float w = W[(size_t)k * 6144];
            a0 += sv[k] * w; a1 += sv[1024 + k] * w; a2 += sv[2048 + k] * w; a3 += sv[3072 + k] * w; a4 += sv[4096 + k] * w; }
        red[(wave * 5 + 0) * 64 + lane] = a0; red[(wave * 5 + 1) * 64 + lane] = a1; red[(wave * 5 + 2) * 64 + lane] = a2; red[(wave * 5 + 3) * 64 + lane] = a3; red[(wave * 5 + 4) * 64 + lane] = a4;
        __syncthreads();
        if (tid < 320) { const int j = tid >> 6, col = tid & 63; float s = 0.f;
#pragma unroll
            for (int w = 0; w < 8; ++w) s += red[(w * 5 + j) * 64 + col];
            MOD[(size_t)(l * 5 + j) * 6144 + cb * 64 + col] = s + mod_b[l * 6144 + cb * 64 + col]; }
        __syncthreads();
    }
    for (int i = blockIdx.x + G * tid; i < 512; i += G * 512) {
        const int p = i >> 3, f = i & 7;
        const double fr[8] = {1.0, 0.31622776601683794, 0.1, 0.031622776601683794, 0.01, 0.0031622776601683794, 0.001, 0.00031622776601683794};
        double th = 1.0;
#pragma unroll
        for (int q = 0; q < 8; ++q) th = (f == q) ? fr[q] : th;
        const double t2 = th * th; double cs = 1.0, sn = th, tc = 1.0, ts = th;
#pragma unroll
        for (int n = 1; n <= 12; ++n) { tc = -tc * t2 * (1.0 / (double)((2 * n - 1) * (2 * n))); ts = -ts * t2 * (1.0 / (double)((2 * n) * (2 * n + 1))); cs += tc; sn += ts; }
        double cr = 1.0, sr = 0.0, bc = cs, bs = sn;
#pragma unroll
        for (int bit = 0; bit < 6; ++bit) { if ((p >> bit) & 1) { const double nc = cr * bc - sr * bs, ns = sr * bc + cr * bs; cr = nc; sr = ns; }
            const double b2c = bc * bc - bs * bs, b2s = 2.0 * bc * bs; bc = b2c; bs = b2s; }
        float* R = (float*)(ws + WS_ROPE); R[i] = (float)cr; R[512 + i] = (float)sr;
    }
    for (int l = 0; l < 2; ++l) { u32x4* z = (u32x4*)(ws + WS_WIN + (size_t)l * NWIN * 1024 * 2 + (size_t)2592 * 1024 * 2);
        for (int i = blockIdx.x * 512 + tid; i < 224 * 1024 * 2 / 16; i += G * 512) z[i] = (u32x4){0u, 0u, 0u, 0u}; }
    __syncthreads();
    tr_range(P, ws, lds, wave, lane, blockIdx.x * 8 + wave, G * 8, IT_LAYER);
    __syncthreads();
}

DI void phase_norm(const void* srcL, int srcL_bf16, const float* srcC, int nrows, const float* g, const float* mod, int shoff, int scoff, bf16_t* U, const float* part, int npart, float* wb, int wave, int lane, int G) {
    const int gw = blockIdx.x * 8 + wave, NGW = G * 8;
    constexpr int NR = 3;
#define NCOL(j) ((((j) >> 1) * 512) + 8 * lane + ((j) & 1) * 4)
    for (int row0 = gw; row0 < nrows; row0 += NR * NGW) {
        f32x4 v[NR][4]; float ss[NR];
#pragma unroll
        for (int q = 0; q < NR; ++q) { const int rq = row0 + q * NGW; const bool has = rq < nrows; const int row = has ? rq : row0;
            if (row < NLAT && srcL_bf16) { const bf16_t* sb = (const bf16_t*)srcL + (size_t)row * DM + 8 * lane;
#pragma unroll
                for (int gq = 0; gq < 2; ++gq) { const u32x4 w = *(const u32x4*)(sb + 512 * gq); v[q][2 * gq] = (f32x4){bflo(w.x), bfhi(w.x), bflo(w.y), bfhi(w.y)}; v[q][2 * gq + 1] = (f32x4){bflo(w.z), bfhi(w.z), bflo(w.w), bfhi(w.w)}; } }
            else { const float* src = row < NLAT ? (const float*)srcL + (size_t)row * DM : srcC + (size_t)(row - NLAT) * DM;
#pragma unroll
                for (int j = 0; j < 4; ++j) v[q][j] = *(const f32x4*)(src + NCOL(j)); }
            if (row >= NLAT && npart > 0) {
                for (int s = 0; s < npart; ++s) { const float* pr = part + ((size_t)s * NCTX + (row - NLAT)) * DM;
#pragma unroll
                    for (int j = 0; j < 4; ++j) v[q][j] += *(const f32x4*)(pr + NCOL(j)); }
                if (has) {
#pragma unroll
                    for (int j = 0; j < 4; ++j) *(f32x4*)(wb + (size_t)(row - NLAT) * DM + NCOL(j)) = v[q][j]; } } }
#pragma unroll
        for (int q = 0; q < NR; ++q) { ss[q] = 0.f;
#pragma unroll
            for (int j = 0; j < 4; ++j) ss[q] += (v[q][j].x * v[q][j].x + v[q][j].y * v[q][j].y) + (v[q][j].z * v[q][j].z + v[q][j].w * v[q][j].w); }
#pragma unroll
        for (int q = 0; q < NR; ++q) { const int row = row0 + q * NGW; if (row >= nrows) break;
            const float* md = mod + (row < NLAT ? (row >> 12) : 4) * 6144;
            const float r = rsqrtf(wave_sum(lane, ss[q]) * (1.f / DM) + 1e-6f);
#pragma unroll
            for (int gq = 0; gq < 2; ++gq) { u32x4 w;
#pragma unroll
                for (int hh = 0; hh < 2; ++hh) { const int j = 2 * gq + hh, col = NCOL(j);
                    const f32x4 gv = *(const f32x4*)(g + col), sc = *(const f32x4*)(md + scoff + col), sh = *(const f32x4*)(md + shoff + col);
                    const f32x4 o = v[q][j] * r * gv * (sc + 1.f) + sh;
                    if (hh == 0) { w.x = pk2(o.x, o.y); w.y = pk2(o.z, o.w); } else { w.z = pk2(o.x, o.y); w.w = pk2(o.z, o.w); } }
                *(u32x4*)(U + (size_t)row * DM + 512 * gq + 8 * lane) = w; } }
    }
#undef NCOL
}

struct EpiWin {
    static constexpr bool PERM = true, AFTER_DRAIN = false;
    unsigned char* ws; const float *qg, *kg, *gate_b;
    DI void operator()(const f32x4 (&acc)[2][2][4][2], const pg8::Unit& u, int wr, int wc, int fr, int fq) const {
        bf16_t *PM = (bf16_t*)(ws + WS_PM), *AQ = (bf16_t*)(ws + WS_AQ), *AK = (bf16_t*)(ws + WS_AK), *AVT = (bf16_t*)(ws + WS_AVT), *PC = (bf16_t*)(ws + WS_PC), *MKT = (bf16_t*)(ws + WS_MKT), *MVT = (bf16_t*)(ws + WS_MVT);
        float* GT = (float*)(ws + WS_GATE); const float* rope = (const float*)(ws + WS_ROPE);
        const int pn = u.pn, rowt = u.pm * 256; const bool lat = rowt < NLAT;
        const int b = lat ? (rowt >> 12) : ((rowt - NLAT) >> 8), pos0 = lat ? 256 + (rowt & 4095) : 0;
        const int rl0 = wr * 64 + fr, cl0 = wc * 32 + 8 * fq, lane = fr + 16 * fq;
        if (pn < 4 || (pn >= 7 && pn < 10)) {
            const float sc = (pn == 1) ? 0.125f : 1.f;
            if (pn != 2) {
            bf16_t* base = pn < 4 ? PM : PC; const int ldc = pn < 4 ? 1024 : 768, coff = pn < 4 ? pn * 256 : (pn - 7) * 256;
#pragma unroll
            for (int ai = 0; ai < 2; ++ai)
#pragma unroll
                for (int m = 0; m < 4; ++m) { const int row = rowt + 128 * ai + rl0 + 16 * m;
#pragma unroll
                    for (int bj = 0; bj < 2; ++bj) { const f32x4 v0 = acc[ai][bj][m][0] * sc, v1 = acc[ai][bj][m][1] * sc; u32x4 w; w.x = pk2(v0[0], v0[1]); w.y = pk2(v0[2], v0[3]); w.z = pk2(v1[0], v1[1]); w.w = pk2(v1[2], v1[3]);
                        *(u32x4*)(base + (size_t)row * ldc + coff + 128 * bj + cl0) = w; }
                    CFENCE(); }
            }
            if (pn == 1 || pn == 2) { bf16_t* T = (pn == 1 ? MKT : MVT) + (size_t)(b * 256 + (wc >> 1) * 64 + 32 * (wc & 1) + 8 * fq) * NPOS + pos0 + rl0;
#pragma unroll
                for (int ai = 0; ai < 2; ++ai)
#pragma unroll
                    for (int m = 0; m < 4; ++m) { bf16_t* Tp = T + 128 * ai + 16 * m;
#pragma unroll
                        for (int bj = 0; bj < 2; ++bj)
#pragma unroll
                            for (int n = 0; n < 2; ++n)
#pragma unroll
                                for (int i = 0; i < 4; ++i) Tp[(size_t)(128 * bj + 4 * n + i) * NPOS] = f2bf(acc[ai][bj][m][n][i] * sc);
                        CFENCE(); } }
        } else if (pn == 4 || pn == 5) {
            const float* g = pn == 4 ? qg : kg; const float osc = pn == 4 ? 0.17677669529663687f * 1.4426950408889634f : 1.f;
            float gv[8];
#pragma unroll
            for (int k = 0; k < 8; ++k) gv[k] = g[8 * fq + k];
#pragma unroll
            for (int ai = 0; ai < 2; ++ai)
#pragma unroll
                for (int m = 0; m < 4; ++m) { const int rl = 128 * ai + rl0 + 16 * m; const int t = (rowt & 4095) + rl; const int p = (fq >> 1) ? (t & 63) : (t >> 6);
#pragma unroll
                    for (int bj = 0; bj < 2; ++bj) { float y[8]; float ss = 0.f;
#pragma unroll
                        for (int k = 0; k < 8; ++k) { y[k] = acc[ai][bj][m][k >> 2][k & 3]; ss += y[k] * y[k]; }
                        ss += shx(lane, ss, 16); ss += shx(lane, ss, 32);
                        const float r = rsqrtf(ss * (1.f / 32.f) + 1e-6f);
#pragma unroll
                        for (int k = 0; k < 8; ++k) y[k] = y[k] * r * gv[k];
                        if (lat) {
#pragma unroll
                            for (int k = 0; k < 8; ++k) { const float cs = rope[p * 8 + k], sn = rope[512 + p * 8 + k]; const float pr = shx(lane, y[k], 16);
                                y[k] = (fq & 1) ? (y[k] * cs + pr * sn) : (y[k] * cs - pr * sn); } }
                        u32x4 w; w.x = pk2(y[0] * osc, y[1] * osc); w.y = pk2(y[2] * osc, y[3] * osc); w.z = pk2(y[4] * osc, y[5] * osc); w.w = pk2(y[6] * osc, y[7] * osc);
                        if (pn == 4) *(u32x4*)(AQ + (size_t)(rowt + rl) * 256 + 128 * bj + cl0) = w;
                        else *(u32x4*)(AK + ((size_t)b * NPOS + pos0 + rl) * 256 + 128 * bj + cl0) = w; }
                    CFENCE(); }
        } else if (pn == 6) {
            bf16_t* T = AVT + (size_t)(b * 256 + (wc >> 1) * 64 + 32 * (wc & 1) + 8 * fq) * NPOS + pos0 + rl0;
#pragma unroll
            for (int ai = 0; ai < 2; ++ai)
#pragma unroll
                for (int m = 0; m < 4; ++m) { bf16_t* Tp = T + 128 * ai + 16 * m;
#pragma unroll
                    for (int bj = 0; bj < 2; ++bj)
#pragma unroll
                        for (int n = 0; n < 2; ++n)
#pragma unroll
                            for (int i = 0; i < 4; ++i) Tp[(size_t)(128 * bj + 4 * n + i) * NPOS] = f2bf(acc[ai][bj][m][n][i]);
                    CFENCE(); }
        } else {
            if (wc == 0 && fq < 2) {
#pragma unroll
                for (int ai = 0; ai < 2; ++ai)
#pragma unroll
                    for (int m = 0; m < 4; ++m) { const int row = rowt + 128 * ai + rl0 + 16 * m; float o[8];
#pragma unroll
                        for (int k = 0; k < 8; ++k) { const int col = 8 * fq + k; float v = acc[ai][0][m][k >> 2][k & 3] + gate_b[col]; if ((col >> 2) & 1) v = logsigmoidf_(v); o[k] = v; }
                        *(f32x4*)(GT + (size_t)row * 16 + 8 * fq) = (f32x4){o[0], o[1], o[2], o[3]}; *(f32x4*)(GT + (size_t)row * 16 + 8 * fq + 4) = (f32x4){o[4], o[5], o[6], o[7]}; } }
        }
    }
};
struct EpiRes {
    static constexpr bool PERM = true, AFTER_DRAIN = false;
    const void* base; void* out; const float* gate; int base_bf16, out_bf16;
    DI void operator()(const f32x4 (&acc)[2][2][4][2], const pg8::Unit& u, int wr, int wc, int fr, int fq) const {
        const int rowt = u.pm * 256; const float* gv = gate + (rowt >> 12) * 6144; const int col0 = u.pn * 256 + wc * 32 + 8 * fq;
        f32x4 g4[2][2];
#pragma unroll
        for (int bj = 0; bj < 2; ++bj)
#pragma unroll
            for (int n = 0; n < 2; ++n) g4[bj][n] = *(const f32x4*)(gv + col0 + 128 * bj + 4 * n);
#pragma unroll
        for (int ai = 0; ai < 2; ++ai)
#pragma unroll
            for (int m = 0; m < 4; ++m) { const size_t off = (size_t)(rowt + 128 * ai + 64 * wr + 16 * m + fr) * DM + col0;
#pragma unroll
                for (int bj = 0; bj < 2; ++bj) { f32x4 b0, b1;
                    if (base_bf16) { const u32x4 w = *(const u32x4*)((const bf16_t*)base + off + 128 * bj); b0 = (f32x4){bflo(w.x), bfhi(w.x), bflo(w.y), bfhi(w.y)}; b1 = (f32x4){bflo(w.z), bfhi(w.z), bflo(w.w), bfhi(w.w)}; }
                    else { b0 = *(const f32x4*)((const float*)base + off + 128 * bj); b1 = *(const f32x4*)((const float*)base + off + 128 * bj + 4); }
                    const f32x4 h0 = b0 + g4[bj][0] * acc[ai][bj][m][0], h1 = b1 + g4[bj][1] * acc[ai][bj][m][1];
                    if (out_bf16) { u32x4 w; w.x = pk2(h0[0], h0[1]); w.y = pk2(h0[2], h0[3]); w.z = pk2(h1[0], h1[1]); w.w = pk2(h1[2], h1[3]); *(u32x4*)((bf16_t*)out + off + 128 * bj) = w; }
                    else { *(f32x4*)((float*)out + off + 128 * bj) = h0; *(f32x4*)((float*)out + off + 128 * bj + 4) = h1; } }
                CFENCE(); }
    }
};
struct EpiPart {
    static constexpr bool PERM = false, AFTER_DRAIN = false;
    float* part; const float* gate;
    DI void operator()(const f32x4 (&acc)[2][2][4][2], const pg8::Unit& u, int wr, int wc, int fr, int fq) const {
        const int col0 = (u.pn & 255) * 256 + wc * 32 + 4 * fq;
        float* os = part + (size_t)(u.pn >> 8) * NCTX * DM + (size_t)(u.pm * 256 + 64 * wr + fr) * DM + col0;
        f32x4 g4[2][2];
#pragma unroll
        for (int bj = 0; bj < 2; ++bj)
#pragma unroll
            for (int n = 0; n < 2; ++n) g4[bj][n] = *(const f32x4*)(gate + col0 + 128 * bj + 16 * n);
#pragma unroll
        for (int ai = 0; ai < 2; ++ai)
#pragma unroll
            for (int m = 0; m < 4; ++m) { float* o = os + (size_t)(128 * ai + 16 * m) * DM;
#pragma unroll
                for (int bj = 0; bj < 2; ++bj)
#pragma unroll
                    for (int n = 0; n < 2; ++n) *(f32x4*)(o + 128 * bj + 16 * n) = g4[bj][n] * acc[ai][bj][m][n];
                CFENCE(); }
    }
};
struct EpiSwiglu {
    static constexpr bool PERM = true, AFTER_DRAIN = false;
    bf16_t* HF;
    DI void operator()(const f32x4 (&acc)[2][2][4][2], const pg8::Unit& u, int wr, int wc, int fr, int fq) const {
        const int col = u.pn * 128 + wc * 32 + 8 * fq;
#pragma unroll
        for (int ai = 0; ai < 2; ++ai)
#pragma unroll
            for (int m = 0; m < 4; ++m) { const int row = u.pm * 256 + 128 * ai + 64 * wr + 16 * m + fr; float o[8];
#pragma unroll
                for (int k = 0; k < 8; ++k) { const float gg = acc[ai][0][m][k >> 2][k & 3], up = acc[ai][1][m][k >> 2][k & 3]; o[k] = gg * sigmoidf_(gg) * up; }
                u32x4 w; w.x = pk2(o[0], o[1]); w.y = pk2(o[2], o[3]); w.z = pk2(o[4], o[5]); w.w = pk2(o[6], o[7]);
                *(u32x4*)(HF + (size_t)row * DFF + col) = w; }
    }
};

DI int pos_row(int b, int pos) { return pos < CTXL ? NLAT + b * CTXL + pos : b * SEQ + (pos - CTXL); }

DI void mlstm_local(LAS unsigned char* lds, int wave, int lane, int item, const bf16_t* MKT, const bf16_t* MVT, const float* GT, float* CL, float* NL, float* ML, float* BT) {
    const int c = item % NCH, seq = item / NCH, dir = seq & 1, bh = seq >> 1, b = bh >> 2, hd = bh & 3, p0 = 64 * c;
    const float* gr = GT + (size_t)pos_row(b, p0 + lane) * 16 + dir * 8 + hd;
    const float iv = gr[0], fv = gr[4];
    float pre = fv;
#pragma unroll
    for (int o = 1; o < 64; o <<= 1) { const float t = shu(lane, pre, o); if (lane >= o) pre += t; }
    const float tot = bperm(pre, 63);
    const float bs = dir ? (tot - pre + fv) : pre;
    const float gs = tot - bs + iv;
    const float mloc = wave_max(lane, gs);
    const float es = __expf(gs - mloc);
    LAS float* ew = (LAS float*)(lds + wave * 2048);
    CFENCE(); ew[lane] = es; CFENCE();
    asm volatile("s_waitcnt lgkmcnt(0)" ::: "memory");
    const int r = lane & 31, h = lane >> 5;
    f32x16 acc[2][2];
#pragma unroll
    for (int a = 0; a < 2; ++a)
#pragma unroll
        for (int bb = 0; bb < 2; ++bb) acc[a][bb] = zero16();
    const bf16_t* vt = MVT + (size_t)(bh * 64) * NPOS + p0; const bf16_t* kt = MKT + (size_t)(bh * 64) * NPOS + p0;
#pragma unroll
    for (int ks = 0; ks < 4; ++ks) { const int off = 16 * ks + 8 * h;
        const f32x4 e0 = *(const LAS f32x4*)(ew + off), e1 = *(const LAS f32x4*)(ew + off + 4);
        bf16x8 af[2], bfv[2];
#pragma unroll
        for (int vb = 0; vb < 2; ++vb) af[vb] = *(const bf16x8*)(vt + (size_t)(32 * vb + r) * NPOS + off);
#pragma unroll
        for (int kb = 0; kb < 2; ++kb) { const u32x4 w = *(const u32x4*)(kt + (size_t)(32 * kb + r) * NPOS + off); u32x4 o;
            o.x = pk2(bflo(w.x) * e0[0], bfhi(w.x) * e0[1]); o.y = pk2(bflo(w.y) * e0[2], bfhi(w.y) * e0[3]); o.z = pk2(bflo(w.z) * e1[0], bfhi(w.z) * e1[1]); o.w = pk2(bflo(w.w) * e1[2], bfhi(w.w) * e1[3]);
            bfv[kb] = __builtin_bit_cast(bf16x8, o); }
#pragma unroll
        for (int vb = 0; vb < 2; ++vb)
#pragma unroll
            for (int kb = 0; kb < 2; ++kb) acc[vb][kb] = MFMA32(af[vb], bfv[kb], acc[vb][kb]);
    }
    float* cl = CL + (size_t)item * 4096;
#pragma unroll
    for (int vb = 0; vb < 2; ++vb)
#pragma unroll
        for (int kb = 0; kb < 2; ++kb)
#pragma unroll
            for (int i = 0; i < 16; ++i) cl[(32 * vb + crow(i, h)) * 64 + 32 * kb + r] = acc[vb][kb][i];
    float nacc = 0.f; const bf16_t* krow = kt + (size_t)lane * NPOS;
#pragma unroll
    for (int q = 0; q < 8; ++q) { const u32x4 w = *(const u32x4*)(krow + 8 * q); const f32x4 e0 = *(const LAS f32x4*)(ew + 8 * q), e1 = *(const LAS f32x4*)(ew + 8 * q + 4);
        nacc += bflo(w.x) * e0[0] + bfhi(w.x) * e0[1] + bflo(w.y) * e0[2] + bfhi(w.y) * e0[3] + bflo(w.z) * e1[0] + bfhi(w.z) * e1[1] + bflo(w.w) * e1[2] + bfhi(w.w) * e1[3]; }
    NL[(size_t)item * 64 + lane] = nacc;
    if (lane == 0) { ML[item] = mloc; BT[item] = tot; }
    asm volatile("s_waitcnt lgkmcnt(0)" ::: "memory"); CFENCE();
}

DI void mlstm_scan(LAS unsigned char* lds, int tid, int item, const float* CL, const float* NL, const float* ML, const float* BT, bf16_t* CS, float* NS, float* MS) {
    const int seq = item >> 3, part = item & 7, dir = seq & 1, e = part * 512 + tid;
    LAS float* sc = (LAS float*)lds;
    LAS float* co = sc + 2 * NCH;
    __syncthreads();
    if (tid < NCH) { const int c = dir ? (tid < 4 ? 3 - tid : 71 - tid) : tid; sc[2 * tid] = BT[seq * NCH + c]; sc[2 * tid + 1] = ML[seq * NCH + c]; }
    __syncthreads();
    if (tid < 64) {
        const int lane = tid; const float bt = sc[2 * lane], ml = sc[2 * lane + 1]; float A = bt, C = ml;
#pragma unroll
        for (int o = 1; o < 64; o <<= 1) { const float Ap = shu(lane, A, o), Cp = shu(lane, C, o); if (lane >= o) { C = fmaxf(Cp + A, C); A = Ap + A; } }
        const float mnext = fmaxf(A, C);
        const float mprev = shu(lane, mnext, 1); const float m = lane == 0 ? 0.f : mprev;
        co[2 * lane] = __expf(bt + m - mnext); co[2 * lane + 1] = __expf(ml - mnext);
        { const int c = dir ? (lane < 4 ? 3 - lane : 71 - lane) : lane; if (part == 0) MS[seq * NCH + c] = m; }
        float mm = bperm(mnext, 63);
        if (lane == 0) { for (int j = 64; j < NCH; ++j) { const int c = dir ? 71 - j : j; const float b2 = sc[2 * j], l2 = sc[2 * j + 1];
            if (part == 0) MS[seq * NCH + c] = mm;
            const float mn = fmaxf(b2 + mm, l2); co[2 * j] = __expf(b2 + mm - mn); co[2 * j + 1] = __expf(l2 - mn); mm = mn; } } }
    float cl[NCH];
#pragma unroll
    for (int j = 0; j < NCH; ++j) { const int c = dir ? (j < 4 ? 3 - j : 71 - j) : j; cl[j] = CL[(size_t)(seq * NCH + c) * 4096 + e]; }
    __syncthreads();
    float C = 0.f, n = 0.f; const bool don = (part == 0 && tid < 64);
#pragma unroll
    for (int j = 0; j < NCH; ++j) { const int c = dir ? (j < 4 ? 3 - j : 71 - j) : j; const int idx = seq * NCH + c;
        CS[(size_t)idx * 4096 + e] = f2bf(C);
        if (don) NS[(size_t)idx * 64 + tid] = n;
        const float a = co[2 * j], bb = co[2 * j + 1];
        C = a * C + bb * cl[j]; if (don) n = a * n + bb * NL[(size_t)idx * 64 + tid]; }
}

DI void mlstm_out(LAS unsigned char* lds, int wave, int lane, int item, const bf16_t* PM, const bf16_t* MVT, const float* GT, const bf16_t* CS, const float* NS, const float* MS, const float* ng, bf16_t* Y) {
    const int th = item & 1, c = (item >> 1) % NCH, bh = (item >> 1) / NCH, b = bh >> 2, hd = bh & 3, p0 = 64 * c;
    const int r = lane & 31, h = lane >> 5, tl = 32 * th + r;
    LAS float* T0 = (LAS float*)(lds + wave * 2048);
    const int rowbase = pos_row(b, p0);
    const bf16_t* qp = PM + (size_t)(rowbase + tl) * 1024 + hd * 64 + 8 * h;
    bf16x8 qf[4];
#pragma unroll
    for (int ks = 0; ks < 4; ++ks) qf[ks] = *(const bf16x8*)(qp + 16 * ks);
    f32x16 St[2];
#pragma unroll
    for (int sb = 0; sb < 2; ++sb) { St[sb] = zero16(); const bf16_t* kp = PM + (size_t)(rowbase + 32 * sb + pi32(r)) * 1024 + 256 + hd * 64 + 8 * h;
#pragma unroll
        for (int ks = 0; ks < 4; ++ks) { const bf16x8 kf = *(const bf16x8*)(kp + 16 * ks); St[sb] = MFMA32(kf, qf[ks], St[sb]); } }
    __builtin_amdgcn_sched_barrier(0); CFENCE();
    f32x16 htot[2]; htot[0] = zero16(); htot[1] = zero16();
    const bf16_t* vt = MVT + (size_t)(bh * 64) * NPOS + p0;
#pragma nounroll
    for (int d = 0; d < 2; ++d) {
        LAS float* T = T0;
        int tlo = tl, ho = h; asm volatile("" : "+v"(tlo), "+v"(ho));
        const int idx = (bh * 2 + d) * NCH + c; const bf16_t* cs = CS + (size_t)idx * 4096;
        float bmine, mmine, einter, thr;
        bf16x8 cfp[4][2];
#pragma unroll
        for (int ks = 0; ks < 4; ++ks)
#pragma unroll
            for (int vb = 0; vb < 2; ++vb) cfp[ks][vb] = *(const bf16x8*)(cs + (32 * vb + r) * 64 + 16 * ks + 8 * ho);
        {
            const float* gr = GT + (size_t)(rowbase + lane) * 16 + d * 8 + hd; const float iv = gr[0], fv = gr[4];
            float pre = fv;
#pragma unroll
            for (int o = 1; o < 64; o <<= 1) { const float t = shu(lane, pre, o); if (lane >= o) pre += t; }
            const float tot = bperm(pre, 63);
            const float bs = d ? (tot - pre + fv) : pre;
            const float ws_ = iv - bs;
            float a = ws_;
#pragma unroll
            for (int o = 1; o < 64; o <<= 1) { const float tu = shu(lane, a, o), td = shd(lane, a, o); const float t = d ? td : tu; const bool ok = d ? (lane + o < 64) : (lane >= o); if (ok) a = fmaxf(a, t); }
            const float mst = MS[idx];
            const float mt = fmaxf(bs + mst, bs + a);
            asm volatile("s_waitcnt lgkmcnt(0)" ::: "memory");
            T[lane] = ws_; T[64 + lane] = NS[(size_t)idx * 64 + lane]; T[128 + lane] = bs; T[192 + lane] = mt;
            asm volatile("s_waitcnt lgkmcnt(0)" ::: "memory");
            bmine = T[128 + tl]; mmine = T[192 + tl];
            einter = __expf(bmine + mst - mmine); thr = __expf(-mmine);
        }
        __builtin_amdgcn_sched_barrier(0); CFENCE();
        f32x16 Hn[2]; Hn[0] = zero16(); Hn[1] = zero16(); float nq = 0.f;
#pragma unroll
        for (int ks = 0; ks < 4; ++ks) {
#pragma unroll
            for (int vb = 0; vb < 2; ++vb) Hn[vb] = MFMA32(cfp[ks][vb], qf[ks], Hn[vb]);
            const f32x4 n0 = *(const LAS f32x4*)(T + 64 + 16 * ks + 8 * h), n1 = *(const LAS f32x4*)(T + 64 + 16 * ks + 8 * h + 4);
            u32x4 qw = __builtin_bit_cast(u32x4, qf[ks]); asm volatile("" : "+v"(qw));
            nq += bflo(qw.x) * n0[0] + bfhi(qw.x) * n0[1] + bflo(qw.y) * n0[2] + bfhi(qw.y) * n0[3] + bflo(qw.z) * n1[0] + bfhi(qw.z) * n1[1] + bflo(qw.w) * n1[2] + bfhi(qw.w) * n1[3]; }
        nq += shx(lane, nq, 32);
#pragma unroll
        for (int vb = 0; vb < 2; ++vb)
#pragma unroll
            for (int i = 0; i < 16; ++i) Hn[vb][i] *= einter;
        __builtin_amdgcn_sched_barrier(0); CFENCE();
        const float bm = bmine - mmine; float dsum = 0.f;
#pragma unroll
        for (int sb = 0; sb < 2; ++sb) {
            bf16x8 pf[2];
#pragma unroll
            for (int ss = 0; ss < 2; ++ss) { const int s0 = 32 * sb + 16 * ss + 8 * h;
                const f32x4 w0 = *(const LAS f32x4*)(T + s0), w1 = *(const LAS f32x4*)(T + s0 + 4); float pv[8];
#pragma unroll
                for (int j = 0; j < 8; ++j) { const int s = s0 + j; const float wv = j < 4 ? w0[j & 3] : w1[j & 3]; const bool ok = d ? (s >= tlo) : (s <= tlo);
                    const float x = ok ? __expf(bm + wv) * St[sb][8 * ss + j] : 0.f; pv[j] = x; dsum += x; }
                u32x4 o; o.x = pk2(pv[0], pv[1]); o.y = pk2(pv[2], pv[3]); o.z = pk2(pv[4], pv[5]); o.w = pk2(pv[6], pv[7]); pf[ss] = __builtin_bit_cast(bf16x8, o); }
            CFENCE();
#pragma unroll
            for (int ss = 0; ss < 2; ++ss)
#pragma unroll
                for (int vb = 0; vb < 2; ++vb) { const bf16x8 vf = *(const bf16x8*)(vt + (size_t)(32 * vb + r) * NPOS + 32 * sb + 16 * ss + 8 * ho); Hn[vb] = MFMA32(vf, pf[ss], Hn[vb]); }
        }
        __builtin_amdgcn_sched_barrier(0); CFENCE();
        dsum += shx(lane, dsum, 32);
        const float den = einter * nq + dsum; const float inv = 1.f / fmaxf(fabsf(den), thr);
#pragma unroll
        for (int vb = 0; vb < 2; ++vb)
#pragma unroll
            for (int i = 0; i < 16; ++i) htot[vb][i] += Hn[vb][i] * inv;
    }
    float ss = 0.f;
#pragma unroll
    for (int vb = 0; vb < 2; ++vb)
#pragma unroll
        for (int i = 0; i < 16; ++i) ss += htot[vb][i] * htot[vb][i];
    ss += shx(lane, ss, 32);
    const float rinv = rsqrtf(ss * (1.f / 64.f) + 1e-6f);
    const size_t row = (size_t)(rowbase + tl);
#pragma unroll
    for (int vb = 0; vb < 2; ++vb)
#pragma unroll
        for (int q = 0; q < 4; ++q) { const int v0 = 32 * vb + 8 * q + 4 * h;
            const u32x2 ow = *(const u32x2*)(PM + row * 1024 + 768 + hd * 64 + v0); const f32x4 g4 = *(const f32x4*)(ng + v0);
            const float o0 = sigmoidf_(bflo(ow.x)) * htot[vb][4 * q + 0] * rinv * g4[0], o1 = sigmoidf_(bfhi(ow.x)) * htot[vb][4 * q + 1] * rinv * g4[1];
            const float o2 = sigmoidf_(bflo(ow.y)) * htot[vb][4 * q + 2] * rinv * g4[2], o3 = sigmoidf_(bfhi(ow.y)) * htot[vb][4 * q + 3] * rinv * g4[3];
            u32x2 w; w.x = pk2(o0, o1); w.y = pk2(o2, o3); *(u32x2*)(Y + row * 1024 + hd * 64 + v0) = w; }
    asm volatile("s_waitcnt lgkmcnt(0)" ::: "memory"); CFENCE();
}

DI void mixer_tile(LAS unsigned char* lds, int tid, int wave, int lane, int tile, const bf16_t* PC, const bf16_t* PoolWT, const float* pool_scale, const float* dw_b,
                   const float* ln_g, const float* ln_b, const bf16_t* PwT, bf16_t* Y) {
    int b, t0, L, seqrow0;
    if (tile < 256) { b = tile >> 6; t0 = (tile & 63) * 64; L = SEQ; seqrow0 = b * SEQ; } else { const int ct = tile - 256; b = ct >> 2; t0 = (ct & 3) * 64; L = CTXL; seqrow0 = NLAT + b * CTXL; }
    const int row0 = seqrow0 + t0;
    LAS unsigned char* A = lds; LAS unsigned char* zt = lds + 49664; LAS float* dww = (LAS float*)(lds + 83456);
    const int r = lane & 31, h = lane >> 5;
#pragma unroll
    for (int q = 0; q < 5; ++q) { const int i = tid + 512 * q, rr = i >> 5, pc = i & 31, t = t0 - 8 + rr; u32x4 v = (u32x4){0u, 0u, 0u, 0u};
        if (t >= 0 && t < L) v = *(const u32x4*)(PC + (size_t)(seqrow0 + t) * 768 + pc * 8);
        *(LAS u32x4*)(A + rr * 528 + pc * 16) = v; }
    __syncthreads();
    { const int ch = tid & 255, tb0 = (tid >> 8) * 32, gi = ch >> 6, w = 2 << gi, wl = w >> 1, wrt = w - 1 - wl;
        const LAS unsigned char* col = A + ch * 2;
        float s = 0.f;
        for (int q = -wl; q <= wrt; ++q) s += bf2f(*(const LAS bf16_t*)(col + (tb0 + q + 8) * 528));
#pragma unroll 4
        for (int tt = 0; tt < 32; ++tt) { const int tloc = tb0 + tt, t = t0 + tloc; const int cnt = min(t + wrt, L - 1) - max(t - wl, 0) + 1;
            const float self = bf2f(*(const LAS bf16_t*)(col + (tloc + 8) * 528));
            *(LAS bf16_t*)(zt + tloc * 528 + ch * 2) = f2bf(s * __builtin_amdgcn_rcpf((float)cnt) - self);
            s += bf2f(*(const LAS bf16_t*)(col + (tloc + 9 + wrt) * 528)) - bf2f(*(const LAS bf16_t*)(col + (tloc + 8 - wl) * 528)); } }
    __syncthreads();
    {
#pragma unroll
        for (int q = 0; q < 6; ++q) { const int i = tid + 512 * q; if (i < 94 * 32) { const int rr = i >> 5, pc = i & 31, t = t0 - 15 + rr; u32x4 o = (u32x4){0u, 0u, 0u, 0u};
            if (t >= 0 && t < L) { const bf16_t* pr = PC + (size_t)(seqrow0 + t) * 768 + pc * 8; const u32x4 a8 = *(const u32x4*)(pr + 256), g8 = *(const u32x4*)(pr + 512);
                o.x = pk2(bflo(a8.x) * sigmoidf_(bflo(g8.x)), bfhi(a8.x) * sigmoidf_(bfhi(g8.x))); o.y = pk2(bflo(a8.y) * sigmoidf_(bflo(g8.y)), bfhi(a8.y) * sigmoidf_(bfhi(g8.y)));
                o.z = pk2(bflo(a8.z) * sigmoidf_(bflo(g8.z)), bfhi(a8.z) * sigmoidf_(bfhi(g8.z))); o.w = pk2(bflo(a8.w) * sigmoidf_(bflo(g8.w)), bfhi(a8.w) * sigmoidf_(bfhi(g8.w))); }
            *(LAS u32x4*)(A + rr * 528 + pc * 16) = o; } }
    }
    {
        const int gi = wave >> 1, dh = wave & 1; bf16x8 af[4];
#pragma unroll
        for (int ks = 0; ks < 4; ++ks) af[ks] = *(const bf16x8*)(PoolWT + (size_t)(gi * 64 + 32 * dh + r) * 64 + 16 * ks + 8 * h);
#pragma unroll
        for (int tb = 0; tb < 2; ++tb) { f32x16 acc = zero16();
#pragma unroll
            for (int ks = 0; ks < 4; ++ks) { const bf16x8 bv = *(const LAS bf16x8*)(zt + (32 * tb + r) * 528 + (gi * 64 + 16 * ks + 8 * h) * 2); acc = MFMA32(af[ks], bv, acc); }
#pragma unroll
            for (int q = 0; q < 4; ++q) { const int d0 = gi * 64 + 32 * dh + 8 * q + 4 * h; const f32x4 ps = *(const f32x4*)(pool_scale + d0);
                u32x2 w; w.x = pk2(acc[4 * q] * ps[0], acc[4 * q + 1] * ps[1]); w.y = pk2(acc[4 * q + 2] * ps[2], acc[4 * q + 3] * ps[3]);
                *(u32x2*)(Y + (size_t)(row0 + 32 * tb + r) * 1024 + 512 + d0) = w; } }
    }
    __syncthreads();
    {
        const f32x4 db = *(const f32x4*)(dw_b + 4 * lane), lg = *(const f32x4*)(ln_g + 4 * lane), lb = *(const f32x4*)(ln_b + 4 * lane);
        for (int q = 0; q < 8; ++q) { const int tloc = wave + 8 * q; f32x4 a = db;
#pragma unroll
            for (int k = 0; k < 31; ++k) { const u32x2 gw = *(const LAS u32x2*)(A + (tloc + k) * 528 + lane * 8); const f32x4 wv = *(const LAS f32x4*)(dww + k * 256 + 4 * lane);
                a[0] += bflo(gw.x) * wv[0]; a[1] += bfhi(gw.x) * wv[1]; a[2] += bflo(gw.y) * wv[2]; a[3] += bfhi(gw.y) * wv[3]; }
            const float mean = wave_sum(lane, (a[0] + a[1]) + (a[2] + a[3])) * (1.f / 256.f); const f32x4 dv = a - mean;
            const float var = wave_sum(lane, (dv[0] * dv[0] + dv[1] * dv[1]) + (dv[2] * dv[2] + dv[3] * dv[3])) * (1.f / 256.f); const float rs = rsqrtf(var + 1e-5f);
            const f32x4 xn = dv * rs * lg + lb; u32x2 w; w.x = pk2(xn[0] * sigmoidf_(xn[0]), xn[1] * sigmoidf_(xn[1])); w.y = pk2(xn[2] * sigmoidf_(xn[2]), xn[3] * sigmoidf_(xn[3]));
            *(LAS u32x2*)(zt + tloc * 528 + lane * 8) = w; }
    }
    __syncthreads();
    {
        f32x16 acc[2]; acc[0] = zero16(); acc[1] = zero16();
#pragma unroll 4
        for (int ks = 0; ks < 16; ++ks) { const bf16x8 af = *(const bf16x8*)(PwT + (size_t)(32 * wave + r) * 256 + 16 * ks + 8 * h);
#pragma unroll
            for (int tb = 0; tb < 2; ++tb) { const bf16x8 bv = *(const LAS bf16x8*)(zt + (32 * tb + r) * 528 + (16 * ks + 8 * h) * 2); acc[tb] = MFMA32(af, bv, acc[tb]); } }
#pragma unroll
        for (int tb = 0; tb < 2; ++tb)
#pragma unroll
            for (int q = 0; q < 4; ++q) { const int d0 = 32 * wave + 8 * q + 4 * h; u32x2 w; w.x = pk2(acc[tb][4 * q], acc[tb][4 * q + 1]); w.y = pk2(acc[tb][4 * q + 2], acc[tb][4 * q + 3]);
                *(u32x2*)(Y + (size_t)(row0 + 32 * tb + r) * 1024 + 768 + d0) = w; }
    }
    __syncthreads();
}

template <bool SHIFT> DI void attn_unit(LAS unsigned char* lds, int tid, int wave, int lane, int b, int hd, int qrow0, int ntiles, float lam, float negshift, float outscale,
                  const bf16_t* AQ, const bf16_t* AK, const bf16_t* AVT, const float* subg, bf16_t* Y) {
    const int r = lane & 31, h = lane >> 5; const size_t qrow = (size_t)qrow0 + wave * 32 + r;
    bf16x8 qf[2][2];
#pragma unroll
    for (int m = 0; m < 2; ++m)
#pragma unroll
        for (int ks = 0; ks < 2; ++ks) qf[m][ks] = *(const bf16x8*)(AQ + qrow * 256 + hd * 64 + m * 32 + 16 * ks + 8 * h);
    f32x16 O[2][2];
#pragma unroll
    for (int m = 0; m < 2; ++m)
#pragma unroll
        for (int eb = 0; eb < 2; ++eb) O[m][eb] = zero16();
    float lsum[2] = {0.f, 0.f};
    const int kkey = tid >> 3, piece = tid & 7;
    const bf16_t* kg = AK + ((size_t)b * NPOS + kkey) * 256 + hd * 64 + piece * 8;
    const bf16_t* vg = AVT + ((size_t)((b * 4 + hd) * 64 + kkey)) * NPOS + piece * 8;
    const int stoff = kkey * 144 + piece * 16;
    u32x4 kreg = *(const u32x4*)kg, vreg = *(const u32x4*)vg;
    *(LAS u32x4*)(lds + stoff) = kreg; *(LAS u32x4*)(lds + 9216 + stoff) = vreg;
    __syncthreads();
    const int koff = pi32(r) * 144 + 16 * h, voff = r * 144 + 16 * h;
    for (int tile = 0; tile < ntiles; ++tile) {
        const int cur = tile & 1; const bool more = tile + 1 < ntiles;
        if (more) { kreg = *(const u32x4*)(kg + (size_t)(tile + 1) * 64 * 256); vreg = *(const u32x4*)(vg + (size_t)(tile + 1) * 64); }
        LAS unsigned char* Kt = lds + cur * 18432; LAS unsigned char* Vt = Kt + 9216;
        f32x16 s[2][2];
#pragma unroll
        for (int kb = 0; kb < 2; ++kb)
#pragma unroll
            for (int m = 0; m < 2; ++m)
#pragma unroll
                for (int i = 0; i < 16; ++i) s[kb][m][i] = SHIFT ? negshift : 0.f;
#pragma unroll
        for (int ks = 0; ks < 2; ++ks)
#pragma unroll
            for (int kb = 0; kb < 2; ++kb)
#pragma unroll
                for (int m = 0; m < 2; ++m) { const bf16x8 kf = *(const LAS bf16x8*)(Kt + kb * 32 * 144 + koff + (m * 32 + 16 * ks) * 2); s[kb][m] = MFMA32(kf, qf[m][ks], s[kb][m]); }
#pragma unroll
        for (int kb = 0; kb < 2; ++kb) {
            bf16x8 pf[2][2];
#pragma unroll
            for (int m = 0; m < 2; ++m) { float p[16];
#pragma unroll
                for (int i = 0; i < 16; ++i) { p[i] = __builtin_amdgcn_exp2f(s[kb][m][i]); lsum[m] += p[i]; }
#pragma unroll
                for (int ss = 0; ss < 2; ++ss) { u32x4 o; o.x = pk2(p[8 * ss], p[8 * ss + 1]); o.y = pk2(p[8 * ss + 2], p[8 * ss + 3]); o.z = pk2(p[8 * ss + 4], p[8 * ss + 5]); o.w = pk2(p[8 * ss + 6], p[8 * ss + 7]);
                    pf[m][ss] = __builtin_bit_cast(bf16x8, o); } }
#pragma unroll
            for (int eb = 0; eb < 2; ++eb)
#pragma unroll
                for (int ss = 0; ss < 2; ++ss) { const bf16x8 vf = *(const LAS bf16x8*)(Vt + eb * 32 * 144 + voff + (32 * kb + 16 * ss) * 2);
                    O[0][eb] = MFMA32(vf, pf[0][ss], O[0][eb]); O[1][eb] = MFMA32(vf, pf[1][ss], O[1][eb]); }
        }
        if (more) { LAS unsigned char* nx = lds + (cur ^ 1) * 18432; *(LAS u32x4*)(nx + stoff) = kreg; *(LAS u32x4*)(nx + 9216 + stoff) = vreg; }
        __syncthreads();
    }
    const float l0 = lsum[0] + shx(lane, lsum[0], 32), l1 = lsum[1] + shx(lane, lsum[1], 32);
    const float a0 = 1.f / l0, a1 = lam / l1; float ss = 0.f;
#pragma unroll
    for (int eb = 0; eb < 2; ++eb)
#pragma unroll
        for (int i = 0; i < 16; ++i) { const float o = O[0][eb][i] * a0 - O[1][eb][i] * a1; O[0][eb][i] = o; ss += o * o; }
    ss += shx(lane, ss, 32);
    const float rinv = rsqrtf(ss * (1.f / 64.f) + 1e-6f) * outscale;
#pragma unroll
    for (int eb = 0; eb < 2; ++eb)
#pragma unroll
        for (int q = 0; q < 4; ++q) { const int e0 = 32 * eb + 8 * q + 4 * h; const f32x4 g4 = *(const f32x4*)(subg + e0);
            u32x2 w; w.x = pk2(O[0][eb][4 * q] * rinv * g4[0], O[0][eb][4 * q + 1] * rinv * g4[1]); w.y = pk2(O[0][eb][4 * q + 2] * rinv * g4[2], O[0][eb][4 * q + 3] * rinv * g4[3]);
            *(u32x2*)(Y + qrow * 1024 + 256 + hd * 64 + e0) = w; }
}

#define XB_TMO      128
#define XB_XCNT(j)  (256  + 64 * (j))
#define XB_XSUB(j)  (1280 + 64 * (j))
#define XB_XGEN(j)  (2304 + 64 * (j))
#define XB_TOP      3328
#define XB_TOPGEN   3392
#define XCD_BAR_WORDS 3456
#define XB_SPIN_CAP (1u << 18)

__device__ __forceinline__ unsigned xb_ld(unsigned* p)              { return __hip_atomic_load(p, __ATOMIC_RELAXED, __HIP_MEMORY_SCOPE_AGENT); }
__device__ __forceinline__ unsigned xb_add(unsigned* p, unsigned v) { return __hip_atomic_fetch_add(p, v, __ATOMIC_RELAXED, __HIP_MEMORY_SCOPE_AGENT); }
__device__ __forceinline__ unsigned xb_xcc_id() { return (unsigned)__builtin_amdgcn_s_getreg((3 << 11) | 20) & 0xFu; }
#define XB_SPIN(cond, bar) do { unsigned _sp = 0; while (cond) { __builtin_amdgcn_s_sleep(1); \
    if ((++_sp & 255u) == 0u) { if (xb_ld(&(bar)[XB_TMO])) break; if (_sp > XB_SPIN_CAP) { atomicAdd(&(bar)[XB_TMO], 1u); break; } } } } while (0)

struct XcdBarrier {
    unsigned* bar; unsigned x;
    volatile LAS unsigned* st;
};

__device__ __forceinline__ XcdBarrier xcd_barrier_post(unsigned* bar, volatile LAS unsigned* st) {
    XcdBarrier b; b.bar = bar; b.x = xb_xcc_id(); b.st = st;
    if (threadIdx.x == 0) (void)xb_add(&bar[XB_XCNT(b.x)], 1u);
    return b;
}
__device__ __forceinline__ void xcd_barrier_complete(unsigned* bar, unsigned x, unsigned& nloc, unsigned& nx) {
    const unsigned G = gridDim.x * gridDim.y * gridDim.z;
    unsigned sum, cnt, mine, sp = 0u;
    for (;;) {
        sum = 0u; cnt = 0u; mine = 0u;
#pragma unroll
        for (unsigned j = 0; j < 16; ++j) { const unsigned c = xb_ld(&bar[XB_XCNT(j)]); sum += c; cnt += (c > 0u) ? 1u : 0u; mine = (j == x) ? c : mine; }
        if (sum == G) break;
        __builtin_amdgcn_s_sleep(1);
        if ((++sp & 255u) == 0u) { if (xb_ld(&bar[XB_TMO])) break; if (sp > XB_SPIN_CAP) { atomicAdd(&bar[XB_TMO], 1u); break; } }
    }
    nloc = mine > 0u ? mine : 1u; nx = cnt > 0u ? cnt : 1u;
}

__device__ __forceinline__ void xcd_barrier(const XcdBarrier& b, const int tid_) {
    asm volatile("s_waitcnt vmcnt(0)" ::: "memory");
    __syncthreads();
    if (tid_ == 0) {
        unsigned* bar = b.bar;
        __builtin_amdgcn_s_waitcnt(0);
        unsigned nloc = b.st[0], nx = b.st[1];
        if (nloc == 0u) { xcd_barrier_complete(bar, b.x, nloc, nx); b.st[0] = nloc; b.st[1] = nx; }
        const unsigned old = xb_add(&bar[XB_XSUB(b.x)], 1u);
        const unsigned gen = old / nloc;
        if (old + 1u == (gen + 1u) * nloc) {
            __builtin_amdgcn_fence(__ATOMIC_RELEASE, "agent");
            asm volatile("s_waitcnt vmcnt(0)" ::: "memory");
            const unsigned og = xb_add(&bar[XB_TOP], 1u);
            const unsigned tg = og / nx;
            if (og + 1u == (tg + 1u) * nx) xb_add(&bar[XB_TOPGEN], 1u);
            else XB_SPIN(xb_ld(&bar[XB_TOPGEN]) == tg, bar);
            __builtin_amdgcn_fence(__ATOMIC_ACQUIRE, "agent");
            xb_add(&bar[XB_XGEN(b.x)], 1u);
            asm volatile("s_waitcnt vmcnt(0)" ::: "memory");
        } else {
            XB_SPIN(xb_ld(&bar[XB_XGEN(b.x)]) == gen, bar);
            __builtin_amdgcn_fence(__ATOMIC_ACQUIRE, "agent");
            asm volatile("s_waitcnt vmcnt(0)" ::: "memory");
        }
    }
    __syncthreads();
}

__device__ __forceinline__ void xcd_arrive(unsigned* sb, volatile LAS unsigned* st, const int tid_) {
    asm volatile("s_waitcnt vmcnt(0)" ::: "memory");
    __syncthreads();
    if (tid_ == 0) {
        const unsigned x = xb_xcc_id(); const unsigned nloc = st[0], nx = st[1];
        const unsigned old = xb_add(&sb[XB_XSUB(x)], 1u); const unsigned gen = old / nloc;
        if (old + 1u == (gen + 1u) * nloc) {
            __builtin_amdgcn_fence(__ATOMIC_RELEASE, "agent"); asm volatile("s_waitcnt vmcnt(0)" ::: "memory");
            const unsigned og = xb_add(&sb[XB_TOP], 1u);
            if (og + 1u == (og / nx + 1u) * nx) xb_add(&sb[XB_TOPGEN], 1u);
        }
    }
}
__device__ __forceinline__ void xcd_wait(unsigned* sb, unsigned target, const int tid_) {
    if (tid_ == 0) { unsigned spins = 0; while (xb_ld(&sb[XB_TOPGEN]) < target) { __builtin_amdgcn_s_sleep(1); if (++spins > (1u << 22)) break; }
        __builtin_amdgcn_fence(__ATOMIC_ACQUIRE, "agent"); asm volatile("s_waitcnt vmcnt(0)" ::: "memory"); }
    __syncthreads();
}

__global__ void __launch_bounds__(512, 2) mega(Params P) {
    extern __shared__ __attribute__((aligned(16))) unsigned char lds_raw[];
    LAS unsigned char* lds = (LAS unsigned char*)lds_raw;
    const int G = gridDim.x;
    const int wave_s = __builtin_amdgcn_readfirstlane(threadIdx.x >> 6);
#define PH_BEGIN() int tid; asm volatile("v_mbcnt_lo_u32_b32 %0, -1, 0\n\tv_mbcnt_hi_u32_b32 %0, -1, %0" : "=v"(tid)); tid += wave_s * 64; const int lane = tid & 63, wave = wave_s; (void)lane; (void)wave; \
    __attribute__((address_space(1))) unsigned char* wsg_ = (__attribute__((address_space(1))) unsigned char*)P.ws; asm volatile("" : "+s"(wsg_)); unsigned char* ws = (unsigned char*)wsg_; int l = lq_; asm volatile("" : "+s"(l)); const bool last = (l == 1); (void)last; const float* mod = (const float*)(ws + WS_MOD) + (size_t)l * 5 * 6144; (void)mod
#define WSP(T, off) ((T*)(ws + (off)))
    const int lo = P.ph_lo, hi = P.ph_hi;
#define IN(k) (lo <= (k) && (k) < hi)
#if MK_COOP
#define SEAM(k) do { if (IN(k) && IN((k) + 1)) { __attribute__((address_space(1))) unsigned char* wsbg_ = (__attribute__((address_space(1))) unsigned char*)P.ws; asm volatile("" : "+s"(wsbg_)); unsigned char* wsb_ = (unsigned char*)wsbg_; XcdBarrier bar_; bar_.bar = (unsigned*)(wsb_ + WS_CTL); bar_.x = xb_xcc_id(); bar_.st = (volatile LAS unsigned*)(lds + 131072) + 8; int tb_; asm volatile("v_mbcnt_lo_u32_b32 %0, -1, 0\n\tv_mbcnt_hi_u32_b32 %0, -1, %0" : "=v"(tb_)); tb_ += wave_s * 64; for (int rs_ = 0; rs_ < REP_SYNC; ++rs_) xcd_barrier(bar_, tb_); } } while (0)
#else
#define SEAM(k) do { } while (0)
#endif
    {
        volatile LAS unsigned* MISC = (volatile LAS unsigned*)(lds + 131072);
        if (threadIdx.x < 32) MISC[threadIdx.x] = 0u;
        __syncthreads();
        (void)xcd_barrier_post((unsigned*)(P.ws + WS_CTL), MISC + 8);
        if (P.ph_hi > 1000) cg::this_grid().sync();
    }
#ifndef NO_P0
    if (IN(0)) for (int rp_ = 0; rp_ < REP_P0; ++rp_) { const int lq_ = 0; PH_BEGIN(); phase0(P, lds, tid, wave, lane, G); }
#endif
    SEAM(0);
    for (int lq_ = 0; lq_ < 2; ++lq_) {
        const int pb = 1 + 9 * lq_;
#ifndef NO_NORM
        if (IN(pb + 0)) for (int rp_ = 0; rp_ < REP_NORM; ++rp_) { PH_BEGIN();
            phase_norm(l == 0 ? (const void*)pin(P, 0) : (const void*)P.out, l == 0 ? 0 : 1, l == 0 ? pin(P, 2) : WSP(float, WS_HC), NROW, pin(P, 4) + l * DM, mod, 0, 1024, WSP(bf16_t, WS_U), WSP(const float, WS_PART), l == 0 ? 0 : 11, WSP(float, WS_HC), wave, lane, G); }
#endif
        SEAM(pb + 0);
#ifndef NO_WIN
        if (IN(pb + 1)) for (int rp_ = 0; rp_ < REP_WIN; ++rp_) { PH_BEGIN();
            pg8::Gemm g{WSP(bf16_t, WS_U), WSP(const bf16_t, WS_WIN) + (size_t)l * NWIN * 1024, NROW, NWIN, 1024, 1024}; pg8::StaticOrder S; S.init(NROW, NWIN, G, (int)blockIdx.x);
            EpiWin E{ws, pin(P, 11) + l * 32, pin(P, 12) + l * 32, pin(P, 9) + l * 16};
            pg8::gemm_phase<EpiWin, pg8::StaticOrder, true, true>(lds, g, S, E, wave_s);
        }
#endif
        SEAM(pb + 1);
        if (IN(pb + 4)) { PH_BEGIN();
            const int ntile = last ? 256 : 272, nskip = ntile > G ? ntile - G : 0;
#ifndef NO_MLOC
            { float* NS = WSP(float, WS_NS); float* NL = NS + 32 * NCH * 64; float* MS = NL + 32 * NCH * 64; float* ML = MS + 32 * NCH; float* BT = ML + 32 * NCH;
              const int stride = (G - nskip) * 8;
              if ((int)blockIdx.x >= nskip)
              for (int it = (G - 1 - (int)blockIdx.x) * 8 + wave; it < 32 * NCH; it += stride) mlstm_local(lds, wave, lane, it, WSP(bf16_t, WS_MKT), WSP(bf16_t, WS_MVT), WSP(float, WS_GATE), WSP(float, WS_CL), NL, ML, BT);
              xcd_arrive(WSP(unsigned, WS_CTL) + 4096, (volatile LAS unsigned*)(lds + 131072) + 8, tid); }
#endif
#ifndef NO_TILE
            { LAS float* dww = (LAS float*)(lds + 83456); const float* dw_w = pin(P, 18) + (size_t)l * 31 * 256; for (int i = tid; i < 31 * 256; i += 512) dww[i] = dw_w[i]; }
            for (int t2 = blockIdx.x; t2 < ntile * REP_TILE; t2 += G) { const int t = t2 % ntile;
                mixer_tile(lds, tid, wave, lane, t, WSP(bf16_t, WS_PC), WSP(const bf16_t, WS_POOLW) + (size_t)l * 4 * 64 * 64, pin(P, 17) + l * 256, pin(P, 19) + l * 256, pin(P, 20) + l * 256, pin(P, 21) + l * 256,
                           WSP(const bf16_t, WS_PW) + (size_t)l * 256 * 256, WSP(bf16_t, WS_Y)); }
#endif
#ifndef NO_MLOC
            xcd_wait(WSP(unsigned, WS_CTL) + 4096, (unsigned)(l + 1), tid);
#endif
#ifndef NO_SCAN
            {
                float* NS = WSP(float, WS_NS); float* NL = NS + 32 * NCH * 64; float* MS = NL + 32 * NCH * 64; float* ML = MS + 32 * NCH; float* BT = ML + 32 * NCH;
                unsigned ndone = 0;
                for (int it = blockIdx.x; it < 256; it += G) { mlstm_scan(lds, tid, it, WSP(float, WS_CL), NL, ML, BT, WSP(bf16_t, WS_CS), NS, MS); ++ndone; }
                (void)ndone; xcd_arrive(WSP(unsigned, WS_CTL) + 12288, (volatile LAS unsigned*)(lds + 131072) + 8, tid);
            }
#endif
            const float lam_init = 0.8f - 0.6f * expf(-0.3f * (float)l);
            const float* lq = pin(P, 13) + l * 64; const float* lk = pin(P, 14) + l * 64;
            const float d0 = wave_sum(lane, lane < 32 ? lq[lane] * lk[lane] : 0.f), d1 = wave_sum(lane, lane < 32 ? lq[32 + lane] * lk[32 + lane] : 0.f);
            const float lam = expf(d0) - expf(d1) + lam_init;
            const float mq = wave_max(lane, lane < 32 ? fabsf(pin(P, 11)[l * 32 + lane]) : 0.f), mk = wave_max(lane, lane < 32 ? fabsf(pin(P, 12)[l * 32 + lane]) : 0.f);
            const float negshift = -(5.656854249492381f * 1.4426950408889634f) * mq * mk;
            const int nunit = last ? 256 : 272;
#ifndef NO_ATT
            for (int rp_ = 0; rp_ < REP_ATT; ++rp_)
            for (int uidx = blockIdx.x; uidx < nunit; uidx += G) {
                int bh, qrow0, nt_;
                if (uidx < 256) { bh = uidx >> 4; qrow0 = (bh >> 2) * SEQ + (uidx & 15) * 256; nt_ = NCH; } else { bh = uidx - 256; qrow0 = NLAT + (bh >> 2) * CTXL; nt_ = 4; }
                if (negshift > -64.f) attn_unit<false>(lds, tid, wave, lane, bh >> 2, bh & 3, qrow0, nt_, lam, 0.f, 1.f - lam_init, WSP(bf16_t, WS_AQ), WSP(bf16_t, WS_AK), WSP(bf16_t, WS_AVT), pin(P, 15) + l * 64, WSP(bf16_t, WS_Y));
                else attn_unit<true>(lds, tid, wave, lane, bh >> 2, bh & 3, qrow0, nt_, lam, negshift, 1.f - lam_init, WSP(bf16_t, WS_AQ), WSP(bf16_t, WS_AK), WSP(bf16_t, WS_AVT), pin(P, 15) + l * 64, WSP(bf16_t, WS_Y));
            }
#endif
            __syncthreads();
#ifndef NO_SCAN
            xcd_wait(WSP(unsigned, WS_CTL) + 12288, (unsigned)(l + 1), tid);
#endif
#ifndef NO_MOUT
            { float* NS = WSP(float, WS_NS); float* MS = NS + 2 * 32 * NCH * 64;
            for (int rp_ = 0; rp_ < REP_MOUT; ++rp_)
            for (int it = (((int)blockIdx.x + G - nskip) % G) * 8 + wave; it < 16 * NCH * 2; it += G * 8) { if (last && ((it >> 1) % NCH) < 4) continue;
                mlstm_out(lds, wave, lane, it, WSP(bf16_t, WS_PM), WSP(bf16_t, WS_MVT), WSP(float, WS_GATE), WSP(bf16_t, WS_CS), NS, MS, pin(P, 10) + l * 64, WSP(bf16_t, WS_Y)); } }
#endif
        }
#ifndef NO_P0
        if (IN(pb + 4) && lq_ == 0) { PH_BEGIN(); __syncthreads();
            const int nbusy = G > 64 ? 32 : 0; int first_ = IT_LAYER + ((int)blockIdx.x - nbusy) * 8 + wave; asm volatile("" : "+s"(first_));
            if ((int)blockIdx.x >= nbusy) tr_range(P, ws, lds, wave, lane, first_, (G - nbusy) * 8, 2 * IT_LAYER); __syncthreads(); }
#endif
        SEAM(pb + 4);
#ifndef NO_WOUT
        if (IN(pb + 5)) { PH_BEGIN();
            { pg8::Gemm g{WSP(bf16_t, WS_Y), WSP(const bf16_t, WS_WOUT) + (size_t)l * 1024 * 1024, NLAT, 1024, 1024, 1024}; pg8::StaticOrder S; S.init(NLAT, 1024, G, (int)blockIdx.x);
              EpiRes E{l == 0 ? (const void*)pin(P, 0) : (const void*)P.out, l == 0 ? (void*)P.out : (void*)(ws + WS_HB2), mod + 2048, l == 0 ? 0 : 1, 1};
              pg8::gemm_phase<EpiRes, pg8::StaticOrder, true, true>(lds, g, S, E, wave_s); }
#ifndef NO_CTXW
            if (!last) {
                pg8::Gemm gc{WSP(bf16_t, WS_Y) + (size_t)NLAT * 1024, WSP(const bf16_t, WS_WOUT) + (size_t)l * 1024 * 1024, NCTX, 1024, 256, 1024}; pg8::SplitOrder Sc; Sc.init(NCTX, 1024, 4, 256, G, (int)blockIdx.x);
                EpiPart Ec{WSP(float, WS_PART), mod + 2048 + 4 * 6144};
                pg8::gemm_phase<EpiPart, pg8::SplitOrder, true, true, true>(lds, gc, Sc, Ec, wave_s); }
#endif
        }
#endif
        SEAM(pb + 5);
#ifndef NO_NORM
        if (IN(pb + 6)) for (int rp_ = 0; rp_ < REP_NORM; ++rp_) { PH_BEGIN();
            phase_norm(l == 0 ? (const void*)P.out : (const void*)(ws + WS_HB2), 1, l == 0 ? pin(P, 2) : WSP(float, WS_HC), last ? NLAT : NROW, pin(P, 5) + l * DM, mod, 3072, 4096, WSP(bf16_t, WS_U), WSP(const float, WS_PART), 4, WSP(float, WS_HC), wave, lane, G); }
#endif
        SEAM(pb + 6);
#ifndef NO_FIN
        if (IN(pb + 7)) for (int rp_ = 0; rp_ < REP_FIN; ++rp_) { PH_BEGIN();
            const int Mrows = last ? NLAT : NROW;
            pg8::Gemm g{WSP(bf16_t, WS_U), WSP(const bf16_t, WS_FIN) + (size_t)l * 2 * DFF * 1024, Mrows, 2 * DFF, 1024, 1024}; pg8::StaticOrder S; S.init(Mrows, 2 * DFF, G, (int)blockIdx.x);
            EpiSwiglu E{WSP(bf16_t, WS_HF)};
            pg8::gemm_phase<EpiSwiglu, pg8::StaticOrder, true, true>(lds, g, S, E, wave_s);
        }
#endif
        SEAM(pb + 7);
#ifndef NO_FOUT
        if (IN(pb + 8)) { PH_BEGIN();
            { pg8::Gemm g{WSP(bf16_t, WS_HF), WSP(const bf16_t, WS_FOUT) + (size_t)l * 1024 * DFF, NLAT, 1024, DFF, DFF}; pg8::StaticOrder S; S.init(NLAT, 1024, G, (int)blockIdx.x);
              EpiRes E{l == 0 ? (const void*)P.out : (const void*)(ws + WS_HB2), (void*)P.out, mod + 5120, 1, l == 0 ? 1 : 0};
              pg8::gemm_phase<EpiRes, pg8::StaticOrder, true, true>(lds, g, S, E, wave_s); }
#ifndef NO_CTXF
            if (!last) {
                pg8::Gemm gc{WSP(bf16_t, WS_HF) + (size_t)NLAT * DFF, WSP(const bf16_t, WS_FOUT) + (size_t)l * 1024 * DFF, NCTX, 1024, 256, DFF}; pg8::SplitOrder Sc; Sc.init(NCTX, 1024, 11, 256, G, (int)blockIdx.x);
                EpiPart Ec{WSP(float, WS_PART), mod + 5120 + 4 * 6144};
                pg8::gemm_phase<EpiPart, pg8::SplitOrder, true, true, true>(lds, gc, Sc, Ec, wave_s); }
#endif
        }
#endif
        if (lq_ == 0) SEAM(pb + 8);
    }
#undef IN
#undef SEAM
}

constexpr int NPHASE = 19;
extern "C" void kernel_launch(void* const* d_in, const int* in_sizes, int n_in, void* d_out, int out_size, void* d_ws, size_t ws_size, hipStream_t stream) {
    static int grid = 0;
    if (grid == 0) {
        if (n_in != 26 || out_size != NLAT * DM || ws_size < WS_END) { fprintf(stderr, "kernel_launch: unexpected shapes (n_in %d out %d ws %zu)\n", n_in, out_size, ws_size); grid = -1; return; }
        int dev = 0, cus = 0, per_cu = 0;
        hipGetDevice(&dev); hipDeviceGetAttribute(&cus, hipDeviceAttributeMultiprocessorCount, dev);
        hipFuncSetAttribute((const void*)mega, hipFuncAttributeMaxDynamicSharedMemorySize, LDS_BYTES);
        hipOccupancyMaxActiveBlocksPerMultiprocessor(&per_cu, (const void*)mega, 512, LDS_BYTES);
        if (per_cu < 1) per_cu = 1;
        grid = cus * per_cu;
        (void)hipGetLastError();
    }
    if (grid < 0) return;
    hipMemsetAsync((unsigned char*)d_ws + WS_CTL, 0, CTL_BYTES, stream);
    Params p{};
    for (int i = 0; i < 26; ++i) p.in[i] = (const float*)d_in[i];
    p.out = (float*)d_out; p.ws = (unsigned char*)d_ws;
#if MK_COOP
    p.ph_lo = 0; p.ph_hi = NPHASE;
    void* args[] = {&p};
    hipError_t e = hipLaunchCooperativeKernel((const void*)mega, dim3(grid), dim3(512), args, LDS_BYTES, stream);
    if (e != hipSuccess) fprintf(stderr, "cooperative launch failed: %s (grid %d)\n", hipGetErrorString(e), grid);
#else
    for (int ph = 0; ph < NPHASE; ++ph) { p.ph_lo = ph; p.ph_hi = ph + 1; hipLaunchKernelGGL(mega, dim3(grid), dim3(512), LDS_BYTES, stream, p); }
#endif
}
```

```cpp
#include <hip/hip_runtime.h>
#include <hip/hip_cooperative_groups.h>
#include <cstdio>
#include <cstdint>
namespace cg = cooperative_groups;
namespace pg8 {
#define PG8_LAS __attribute__((address_space(3)))
typedef unsigned short bf16_t;
typedef short bf16x8 __attribute__((ext_vector_type(8)));
typedef float f32x4 __attribute__((ext_vector_type(4)));
typedef unsigned u32x4 __attribute__((ext_vector_type(4)));
constexpr int BM = 256, BK = 64, HALF = 128, HTB = HALF * BK * 2  , STAGE_BYTES = 8 * HTB, NXCD = 8, WGM = 8;

__host__ __device__ __forceinline__ int lds_byte(int r, int c) { const int st = (r >> 4) * 2 + (c >> 5), rr = r & 15, cc = c & 31, ob = rr * 64 + cc * 2; return st * 1024 + (ob ^ (((ob >> 9) & 1) << 5)); }
__host__ __device__ __forceinline__ void stage_rc(int b, int& R, int& C) { const int st = b / 1024, sb = b % 1024, swz = sb ^ (((sb >> 9) & 1) << 5); R = (st >> 1) * 16 + swz / 64; C = (st & 1) * 32 + (swz % 64) / 2; }
__host__ __device__ __forceinline__ int perm32(int rho) { const int n = rho >> 4, i = rho & 15; return 8 * (i >> 2) + 4 * n + (i & 3); }

struct Unit { int pm, pn; };
struct Gemm { const bf16_t* A; const bf16_t* Bt; int M, N, K, ld; };

struct StaticOrder {
    int nM, nN, nwg, G, c;
    __host__ __device__ void init(int M, int N, int G_, int c_) { nM = M / BM; nN = N / BM; nwg = nM * nN; G = G_; c = c_; }
    __host__ __device__ bool next(int i, Unit& u) const {
        const long L = (long)i * G + c; if (L >= nwg) return false;
        int wgid = (int)L; { const int q = nwg / NXCD, r = nwg % NXCD, xcd = wgid % NXCD, off = wgid / NXCD; wgid = (xcd < r ? xcd * (q + 1) : r * (q + 1) + (xcd - r) * q) + off; }
        const int nig = WGM * nN, gid = wgid / nig, fm = gid * WGM, gsz = (nM - fm) < WGM ? (nM - fm) : WGM;
        u.pm = fm + ((wgid % nig) % gsz); u.pn = (wgid % nig) / gsz; return true;
    }
    __device__ __forceinline__ void a_ready(const Unit&) const {}
    __device__ __forceinline__ void done(const Unit&) const {}
};

struct SplitOrder {
    int nN, nsplit, ksub, nitems, G, c;
    __host__ __device__ void init(int M, int N, int nsplit_, int ksub_, int G_, int c_) { nN = N / BM; nsplit = nsplit_; ksub = ksub_; nitems = (M / BM) * nN * nsplit_; G = G_; c = c_; }
    __host__ __device__ bool next(int i, Unit& u) const { const int L = i * G + c; if (L >= nitems) return false; const int t = L / nsplit; u.pm = t / nN; u.pn = (t % nN) | ((L % nsplit) << 8); return true; }
    __device__ __forceinline__ void a_ready(const Unit&) const {}
    __device__ __forceinline__ void done(const Unit&) const {}
};
__device__ __forceinline__ unsigned cvt_pk_bf16(float lo, float hi) { unsigned r; asm volatile("v_cvt_pk_bf16_f32 %0, %1, %2" : "=v"(r) : "v"(lo), "v"(hi)); return r; }
template <class Epi, class Sched, bool ALIGN_EPI = false, bool SP2 = false, bool SPLIT = false>
__device__ __forceinline__ void gemm_phase(PG8_LAS unsigned char* lds, const Gemm g, const Sched& S, const Epi& E, const int wave_s) {
    int tid_op; asm volatile("v_mbcnt_lo_u32_b32 %0, -1, 0\n\tv_mbcnt_hi_u32_b32 %0, -1, %0" : "=v"(tid_op)); tid_op += wave_s * 64;
    const int tid = tid_op, wid = __builtin_amdgcn_readfirstlane(tid >> 6), lane = tid & 63, wr = wid >> 2, wc = wid & 3, fr = lane & 15, fq = lane >> 4;
    const int K = g.K, nt = K / BK;
    unsigned voffA[2], voffB[2];
#pragma unroll
    for (int i = 0; i < 2; ++i) { int R, C; stage_rc(tid * 16 + i * 8192, R, C); const int Rb = Epi::PERM ? ((R & ~31) + perm32(R & 31)) : R;
        voffA[i] = (unsigned)(R * (SPLIT ? g.ld : K) + C) * 2u; voffB[i] = (unsigned)(Rb * (SPLIT ? g.ld : K) + C) * 2u; }
    const size_t kstep = (size_t)(BK * 2);
    const size_t hstep = (size_t)HALF * (SPLIT ? g.ld : K) * 2;
    const size_t tstep = 2 * hstep;
    const unsigned ldsw = (unsigned)wid * 1024u;
    const int aoff = lds_byte(wr * 64 + fr, fq * 8), boff = lds_byte(wc * 32 + fr, fq * 8);
#define PG8_SA(b, h) (((b) * 2 + (h)) * HTB)
#define PG8_SB(b, h) ((4 + (b) * 2 + (h)) * HTB)
#define PG8_STAGE(bufoff, gbase, voff) do { _Pragma("unroll") for (int _i = 0; _i < 2; ++_i) \
        __builtin_amdgcn_global_load_lds((const unsigned*)((const char*)(gbase) + (voff)[_i]), (PG8_LAS unsigned*)(lds + (bufoff) + ldsw + _i * 8192), 16, 0, 0); } while (0)
#define PG8_LDA(dst, b, h) do { _Pragma("unroll") for (int m = 0; m < 4; ++m) _Pragma("unroll") for (int k = 0; k < 2; ++k) dst[m][k] = *(const PG8_LAS bf16x8*)(lds + PG8_SA(b, h) + aoff + m * 2048 + k * 1024); } while (0)
#define PG8_LDB(dst, b, h) do { _Pragma("unroll") for (int n = 0; n < 2; ++n) _Pragma("unroll") for (int k = 0; k < 2; ++k) dst[n][k] = *(const PG8_LAS bf16x8*)(lds + PG8_SB(b, h) + boff + n * 2048 + k * 1024); } while (0)
#define PG8_MMA(ai, bj, At, Bt) do { __builtin_amdgcn_s_setprio(1); _Pragma("unroll") for (int m = 0; m < 4; ++m) _Pragma("unroll") for (int n = 0; n < 2; ++n) _Pragma("unroll") for (int k = 0; k < 2; ++k) \
        acc[ai][bj][m][n] = __builtin_amdgcn_mfma_f32_16x16x32_bf16(Bt[n][k], At[m][k], acc[ai][bj][m][n], 0, 0, 0); __builtin_amdgcn_s_setprio(0); } while (0)
#define PG8_WAIT_V(n) asm volatile("s_waitcnt vmcnt(" #n ")" ::: "memory")
#define PG8_WAIT_L(n) asm volatile("s_waitcnt lgkmcnt(" #n ")" ::: "memory")
#define PG8_BAR __builtin_amdgcn_s_barrier()
#define PG8_SCHED __builtin_amdgcn_sched_barrier(0)
    Unit cur, nxt; int ui = 0;
    if (!S.next(0, cur)) return;
    f32x4 acc[2][2][4][2];
#pragma unroll
    for (int a = 0; a < 2; ++a)
#pragma unroll
        for (int b = 0; b < 2; ++b)
#pragma unroll
            for (int m = 0; m < 4; ++m)
#pragma unroll
                for (int n = 0; n < 2; ++n) acc[a][b][m][n] = (f32x4){0.f, 0.f, 0.f, 0.f};
    bf16x8 At[4][2], B0[2][2], B1[2][2];
    const char* cA = (const char*)g.A + (size_t)cur.pm * tstep + (SPLIT ? (size_t)(cur.pn >> 8) * 512 : 0); const char* cB = (const char*)g.Bt + (size_t)(SPLIT ? (cur.pn & 255) : cur.pn) * tstep + (SPLIT ? (size_t)(cur.pn >> 8) * 512 : 0);
    S.a_ready(cur);
    if constexpr (SP2) {
        PG8_STAGE(PG8_SB(0, 0), cB, voffB); PG8_STAGE(PG8_SB(0, 1), cB + hstep, voffB); PG8_STAGE(PG8_SA(0, 0), cA, voffA); PG8_STAGE(PG8_SA(0, 1), cA + hstep, voffA);
        if (wr == 1) PG8_BAR;
        PG8_WAIT_V(2); PG8_BAR;
        PG8_STAGE(PG8_SB(1, 0), cB + kstep, voffB); PG8_STAGE(PG8_SA(1, 0), cA + kstep, voffA); PG8_STAGE(PG8_SB(1, 1), cB + hstep + kstep, voffB);
        PG8_WAIT_V(6); PG8_BAR;
    } else {
        PG8_STAGE(PG8_SB(0, 0), cB, voffB); PG8_STAGE(PG8_SA(0, 0), cA, voffA); PG8_STAGE(PG8_SB(0, 1), cB + hstep, voffB); PG8_STAGE(PG8_SA(0, 1), cA + hstep, voffA);
        if (wr == 1) PG8_BAR;
        PG8_WAIT_V(4); PG8_BAR;
        PG8_STAGE(PG8_SB(1, 0), cB + kstep, voffB); PG8_STAGE(PG8_SA(1, 0), cA + kstep, voffA); PG8_STAGE(PG8_SB(1, 1), cB + hstep + kstep, voffB);
        PG8_WAIT_V(6); PG8_BAR;
    }
    for (;;) {
        const bool has_next = S.next(ui + 1, nxt);
        const char* nA = has_next ? (const char*)g.A + (size_t)nxt.pm * tstep + (SPLIT ? (size_t)(nxt.pn >> 8) * 512 : 0) : cA; const char* nB = has_next ? (const char*)g.Bt + (size_t)(SPLIT ? (nxt.pn & 255) : nxt.pn) * tstep + (SPLIT ? (size_t)(nxt.pn >> 8) * 512 : 0) : cB;
        for (int t = 0; t < nt; t += 2) {
            const bool last = (t == nt - 2);
            const char* a1 = cA + (size_t)(t + 1) * kstep;
            const char* a2 = last ? nA : cA + (size_t)(t + 2) * kstep; const char* b2 = last ? nB : cB + (size_t)(t + 2) * kstep;
            const char* a3 = a2 + kstep; const char* b3 = b2 + kstep;
            if (last && has_next) S.a_ready(nxt);
            if constexpr (SP2) {
            PG8_LDB(B0, 0, 0); PG8_LDB(B1, 0, 1); PG8_SCHED; PG8_LDA(At, 0, 0); PG8_STAGE(PG8_SA(1, 1), a1 + hstep, voffA);
            PG8_WAIT_V(8); PG8_WAIT_L(0); PG8_BAR; PG8_MMA(0, 0, At, B0); PG8_MMA(0, 1, At, B1); PG8_BAR; PG8_SCHED;
            PG8_LDA(At, 0, 1); PG8_STAGE(PG8_SB(0, 0), b2, voffB); PG8_STAGE(PG8_SB(0, 1), b2 + hstep, voffB); PG8_STAGE(PG8_SA(0, 0), a2, voffA);
            PG8_WAIT_V(8); PG8_WAIT_L(0); PG8_BAR; PG8_MMA(1, 0, At, B0); PG8_MMA(1, 1, At, B1); PG8_BAR; PG8_SCHED;
            PG8_LDB(B0, 1, 0); PG8_LDB(B1, 1, 1); PG8_SCHED; PG8_LDA(At, 1, 0); PG8_STAGE(PG8_SA(0, 1), a2 + hstep, voffA);
            PG8_WAIT_V(8); PG8_WAIT_L(0); PG8_BAR; PG8_MMA(0, 0, At, B0); PG8_MMA(0, 1, At, B1); PG8_BAR; PG8_SCHED;
            PG8_LDA(At, 1, 1); PG8_STAGE(PG8_SB(1, 0), b3, voffB); PG8_STAGE(PG8_SB(1, 1), b3 + hstep, voffB); PG8_STAGE(PG8_SA(1, 0), a3, voffA);
            PG8_WAIT_V(8); PG8_WAIT_L(0); PG8_BAR; PG8_MMA(1, 0, At, B0); PG8_MMA(1, 1, At, B1); PG8_BAR; PG8_SCHED;
            } else {
            PG8_LDB(B0, 0, 0); PG8_SCHED; PG8_LDA(At, 0, 0); PG8_STAGE(PG8_SA(1, 1), a1 + hstep, voffA);
            PG8_WAIT_L(8); PG8_BAR; PG8_WAIT_L(0); PG8_MMA(0, 0, At, B0); PG8_BAR; PG8_SCHED;
            PG8_LDB(B1, 0, 1); PG8_STAGE(PG8_SB(0, 0), b2, voffB);
            PG8_BAR; PG8_WAIT_L(0); PG8_MMA(0, 1, At, B1); PG8_BAR;
            PG8_LDA(At, 0, 1); PG8_STAGE(PG8_SA(0, 0), a2, voffA);
            PG8_BAR; PG8_WAIT_L(0); PG8_MMA(1, 0, At, B0); PG8_BAR; PG8_SCHED;
            PG8_STAGE(PG8_SB(0, 1), b2 + hstep, voffB);
            PG8_WAIT_V(6); PG8_BAR; PG8_MMA(1, 1, At, B1); PG8_BAR;
            PG8_LDB(B0, 1, 0); PG8_SCHED; PG8_LDA(At, 1, 0); PG8_STAGE(PG8_SA(0, 1), a2 + hstep, voffA);
            PG8_WAIT_L(8); PG8_BAR; PG8_WAIT_L(0); PG8_MMA(0, 0, At, B0); PG8_BAR; PG8_SCHED;
            PG8_LDB(B1, 1, 1); PG8_STAGE(PG8_SB(1, 0), b3, voffB);
            PG8_BAR; PG8_WAIT_L(0); PG8_MMA(0, 1, At, B1); PG8_BAR;
            PG8_LDA(At, 1, 1); PG8_STAGE(PG8_SA(1, 0), a3, voffA);
            PG8_BAR; PG8_WAIT_L(0); PG8_MMA(1, 0, At, B0); PG8_BAR; PG8_SCHED;
            PG8_STAGE(PG8_SB(1, 1), b3 + hstep, voffB);
            PG8_WAIT_V(6); PG8_BAR; PG8_MMA(1, 1, At, B1); PG8_BAR;
            }
        }
        if constexpr (ALIGN_EPI) { if (wr == 0) PG8_BAR; }
        if constexpr (!Epi::AFTER_DRAIN) { int ln2_; asm volatile("v_mbcnt_lo_u32_b32 %0, -1, 0\n\tv_mbcnt_hi_u32_b32 %0, -1, %0" : "=v"(ln2_)); E(acc, cur, wr, wc, ln2_ & 15, ln2_ >> 4); S.done(cur); }
        if (!has_next) break;
#pragma unroll
        for (int a = 0; a < 2; ++a)
#pragma unroll
            for (int b = 0; b < 2; ++b)
#pragma unroll
                for (int m = 0; m < 4; ++m)
#pragma unroll
                    for (int n = 0; n < 2; ++n) acc[a][b][m][n] = (f32x4){0.f, 0.f, 0.f, 0.f};
        cur = nxt; cA = nA; cB = nB; ++ui;
        if constexpr (ALIGN_EPI) { if (wr == 1) PG8_BAR; }
    }
    PG8_WAIT_V(0);
    if constexpr (!ALIGN_EPI) { if (wr == 0) PG8_BAR; }
    PG8_BAR;
    if constexpr (Epi::AFTER_DRAIN) { E.fused(acc, cur, wr, wc, fr, fq, lds, wid, lane); S.done(cur); }
#undef PG8_SA
#undef PG8_SB
#undef PG8_STAGE
#undef PG8_LDA
#undef PG8_LDB
#undef PG8_MMA
#undef PG8_WAIT_V
#undef PG8_WAIT_L
#undef PG8_BAR
#undef PG8_SCHED
}
}

#ifndef MK_COOP
#define MK_COOP 1
#endif
#ifndef REP_P0
#define REP_P0 1
#endif
#ifndef REP_NORM
#define REP_NORM 1
#endif
#ifndef REP_WIN
#define REP_WIN 1
#endif
#ifndef REP_TILE
#define REP_TILE 1
#endif
#ifndef REP_MLOC
#define REP_MLOC 1
#endif
#ifndef REP_SCAN
#define REP_SCAN 1
#endif
#ifndef REP_ATT
#define REP_ATT 1
#endif
#ifndef REP_MOUT
#define REP_MOUT 1
#endif
#ifndef REP_FIN
#define REP_FIN 1
#endif
#ifndef REP_RES
#define REP_RES 1
#endif
#ifndef REP_SYNC
#define REP_SYNC 1
#endif
#define DI __device__ __forceinline__
#define LAS __attribute__((address_space(3)))
typedef unsigned short bf16_t;
typedef short bf16x8 __attribute__((ext_vector_type(8)));
typedef float f32x4 __attribute__((ext_vector_type(4)));
typedef float f32x16 __attribute__((ext_vector_type(16)));
typedef unsigned u32x4 __attribute__((ext_vector_type(4)));
typedef unsigned u32x2 __attribute__((ext_vector_type(2)));
typedef float f32x2_t __attribute__((ext_vector_type(2)));
typedef __bf16 bf16x2_t __attribute__((ext_vector_type(2)));
#define MFMA32(a, b, c) __builtin_amdgcn_mfma_f32_32x32x16_bf16((a), (b), (c), 0, 0, 0)
#define CFENCE() asm volatile("" ::: "memory")

DI unsigned pk2(float lo, float hi) { f32x2_t v = {lo, hi}; bf16x2_t b = __builtin_convertvector(v, bf16x2_t); return __builtin_bit_cast(unsigned, b); }
DI float bflo(unsigned w) { return __uint_as_float(w << 16); }
DI float bfhi(unsigned w) { return __uint_as_float(w & 0xffff0000u); }
DI float bf2f(bf16_t u) { return __uint_as_float((unsigned)u << 16); }
DI bf16_t f2bf(float f) { return (bf16_t)(pk2(f, 0.f) & 0xffffu); }
DI int crow(int reg, int h) { return (reg & 3) + 8 * (reg >> 2) + 4 * h; }
DI int pi32(int r) { return (r & 0x13) | ((r & 4) << 1) | ((r & 8) >> 1); }
DI float bperm(float v, int src) { return __int_as_float(__builtin_amdgcn_ds_bpermute(src << 2, __float_as_int(v))); }
DI float shx(int lane, float v, int m) { return bperm(v, lane ^ m); }
DI float shu(int lane, float v, int d) { return bperm(v, lane >= d ? lane - d : lane); }
DI float shd(int lane, float v, int d) { return bperm(v, lane + d < 64 ? lane + d : lane); }
DI float wave_sum(int lane, float v) {
#pragma unroll
    for (int o = 1; o < 64; o <<= 1) v += bperm(v, lane ^ o);
    return v;
}
DI float wave_max(int lane, float v) {
#pragma unroll
    for (int o = 1; o < 64; o <<= 1) v = fmaxf(v, bperm(v, lane ^ o));
    return v;
}
DI float sigmoidf_(float x) { return __builtin_amdgcn_rcpf(1.f + __expf(-x)); }
DI float logsigmoidf_(float x) { const float e = __expf(-fabsf(x)); return fminf(x, 0.f) - __logf(1.f + e); }
DI f32x16 zero16() { f32x16 z; for (int i = 0; i < 16; ++i) z[i] = 0.f; return z; }

constexpr int DM = 1024, NBATCH = 4, SEQ = 4096, CTXL = 256, NLAT = NBATCH * SEQ, NCTX = NBATCH * CTXL, NROW = NLAT + NCTX, NPOS = CTXL + SEQ;
constexpr int DFF = 2816, INC = 2576, NWIN = 2816, NCH = NPOS / 64  ;
constexpr size_t MiB = 1u << 20;
constexpr size_t WS_MOD = 0, WS_ROPE = 256 * 1024, WS_CTL = 512 * 1024, CTL_BYTES = 64 * 1024, WS_WIN = 1 * MiB, WS_WOUT = 12 * MiB, WS_FIN = 16 * MiB, WS_FOUT = 38 * MiB, WS_PW = 49 * MiB, WS_POOLW = 49 * MiB + 256 * 1024,
                 WS_HC = 50 * MiB, WS_U = 54 * MiB, WS_GATE = 88 * MiB, WS_CS = 90 * MiB, WS_NS = 107 * MiB, WS_Y = 109 * MiB, WS_PM = 143 * MiB, WS_AQ = 177 * MiB,
                 WS_AK = WS_AQ + 8 * MiB + 512 * 1024, WS_AVT = WS_AK + 8 * MiB + 512 * 1024, WS_PC = WS_AVT + 8 * MiB + 512 * 1024, WS_MKT = 228 * MiB, WS_MVT = WS_MKT + 8 * MiB + 512 * 1024,
                 WS_END = 247 * MiB, WS_HF = WS_Y, WS_CL = WS_U, WS_PART = 203 * MiB, WS_HB2 = 204 * MiB;
static_assert(WS_PC + (size_t)NROW * 768 * 2 <= WS_MKT && WS_MVT + (size_t)16 * 64 * NPOS * 2 <= WS_END && WS_HF + (size_t)NROW * DFF * 2 <= WS_PART && WS_PART + (size_t)11 * NCTX * DM * 4 <= WS_END, "ws map");
constexpr int LDS_BYTES = 135168;

struct Params { const float* in[26]; float* out; unsigned char* ws; int ph_lo, ph_hi; };

struct TrDesc { const float* W; bf16_t* WT; int ldw, col0, K, row0, kb, nb, ncv; };
DI void tr_load(float (&v)[32], const TrDesc& d, int lane) {
    const int k0 = 64 * d.kb, nn = 32 * d.nb + (lane & 31);
#pragma unroll
    for (int i = 0; i < 32; ++i) { const int kk = 2 * i + (lane >> 5); v[i] = nn < d.ncv ? d.W[(size_t)(k0 + kk) * d.ldw + d.col0 + nn] : 0.f; }
}
DI void tr_store(const float (&v)[32], const TrDesc& d, LAS float* scr, int lane) {
    const int k0 = 64 * d.kb, n0 = 32 * d.nb;
#pragma unroll
    for (int i = 0; i < 32; ++i) { const int kk = 2 * i + (lane >> 5); scr[kk * 33 + (lane & 31)] = v[i]; }
    asm volatile("s_waitcnt lgkmcnt(0)" ::: "memory");
    const int c = lane & 7;
#pragma unroll
    for (int jj = 0; jj < 4; ++jj) { const int n = (lane >> 3) + 8 * jj; const LAS float* s = scr + (8 * c) * 33 + n;
        u32x4 o; o.x = pk2(s[0 * 33], s[1 * 33]); o.y = pk2(s[2 * 33], s[3 * 33]); o.z = pk2(s[4 * 33], s[5 * 33]); o.w = pk2(s[6 * 33], s[7 * 33]);
        *(u32x4*)(d.WT + (size_t)(d.row0 + n0 + n) * d.K + k0 + 8 * c) = o; }
    asm volatile("s_waitcnt lgkmcnt(0)" ::: "memory");
}
constexpr int IT_WIN_A = 16 * 32, IT_WIN_B = 16 * 48, IT_WIN_G = 16, IT_WOUT = 16 * 32, IT_FIN = 16 * 176, IT_FOUT = 44 * 32, IT_PW = 4 * 8, IT_POOL = 8;
constexpr int IT_LAYER = IT_WIN_A + IT_WIN_B + IT_WIN_G + IT_WOUT + IT_FIN + IT_FOUT + IT_PW + IT_POOL;

DI const float* pin(const Params& P, int k) { asm volatile("" : "+s"(k)); return (const float*)(__attribute__((address_space(1))) const float*)P.in[k]; }
DI void tr_range(const Params& P, unsigned char* ws, LAS unsigned char* lds, int wave, int lane, int first, int stride, int end) {
    LAS float* scr = (LAS float*)(lds + wave * 16384);
    auto decode = [&](int itg, TrDesc& d) {
        const int l = itg / IT_LAYER; int r = itg % IT_LAYER; d.ncv = 1 << 30;
        const float* w_in = pin(P, 8) + (size_t)l * 1024 * INC; bf16_t* WinT = (bf16_t*)(ws + WS_WIN) + (size_t)l * NWIN * 1024;
        if (r < IT_WIN_A) { d = TrDesc{w_in, WinT, INC, 0, 1024, 0, r / 32, r % 32, 1 << 30}; return; } r -= IT_WIN_A;
        if (r < IT_WIN_B) { d = TrDesc{w_in, WinT, INC, 1040, 1024, 1024, r / 48, r % 48, 1 << 30}; return; } r -= IT_WIN_B;
        if (r < IT_WIN_G) { d = TrDesc{w_in, WinT, INC, 1024, 1024, 2560, r, 0, 16}; return; } r -= IT_WIN_G;
        if (r < IT_WOUT) { d = TrDesc{pin(P, 23) + (size_t)l * 1024 * 1024, (bf16_t*)(ws + WS_WOUT) + (size_t)l * 1024 * 1024, 1024, 0, 1024, 0, r / 32, r % 32, 1 << 30}; return; } r -= IT_WOUT;
        if (r < IT_FIN) { const int kb = r / 176, nbp = r % 176, pn = nbp >> 3, within = nbp & 7, half = within >> 2, q = within & 3;
            d = TrDesc{pin(P, 24) + (size_t)l * 1024 * 2 * DFF, (bf16_t*)(ws + WS_FIN) + (size_t)l * 2 * DFF * 1024, 2 * DFF, half * DFF + 128 * pn + 32 * q, 1024, 256 * pn + 128 * half + 32 * q, kb, 0, 1 << 30}; return; } r -= IT_FIN;
        if (r < IT_FOUT) { d = TrDesc{pin(P, 25) + (size_t)l * DFF * 1024, (bf16_t*)(ws + WS_FOUT) + (size_t)l * 1024 * DFF, 1024, 0, DFF, 0, r / 32, r % 32, 1 << 30}; return; } r -= IT_FOUT;
        if (r < IT_PW) { d = TrDesc{pin(P, 22) + (size_t)l * 256 * 256, (bf16_t*)(ws + WS_PW) + (size_t)l * 256 * 256, 256, 0, 256, 0, r / 8, r % 8, 1 << 30}; return; } r -= IT_PW;
        { const int g = r >> 1; d = TrDesc{pin(P, 16) + (size_t)(l * 4 + g) * 64 * 64, (bf16_t*)(ws + WS_POOLW) + (size_t)(l * 4 + g) * 64 * 64, 64, 0, 64, 0, 0, r & 1, 1 << 30}; }
    };
    {
        float va[32], vb[32]; TrDesc da, db; int it = first; const int total = end, NGW = stride;
        if (it < total) { decode(it, da); tr_load(va, da, lane); }
        while (it < total) {
            int nx = it + NGW; if (nx < total) { decode(nx, db); tr_load(vb, db, lane); }
            tr_store(va, da, scr, lane); it = nx;
            if (it >= total) break;
            nx = it + NGW; if (nx < total) { decode(nx, da); tr_load(va, da, lane); }
            tr_store(vb, db, scr, lane); it = nx;
        }
    }
}

DI void phase0(const Params& P, LAS unsigned char* lds, int tid, int wave, int lane, int G) {
    unsigned char* ws = P.ws;
    const float* c = P.in[1]; const float* cctx = P.in[3]; const float* mod_w = P.in[6]; const float* mod_b = P.in[7];
    float* MOD = (float*)(ws + WS_MOD);
    LAS float* sv = (LAS float*)lds;
    LAS float* red = (LAS float*)(lds + 20480);
    for (int i = tid; i < 5 * 1024; i += 512) { const int j = i >> 10, k = i & 1023; const float v = j < 4 ? c[j * 1024 + k] : cctx[k]; sv[i] = v / (1.f + expf(-v)); }
    __syncthreads();
    for (int it = blockIdx.x; it < 192; it += G) {
        const int l = it / 96, cb = it % 96;
        const float* W = mod_w + (size_t)l * 1024 * 6144 + cb * 64 + lane;
        float a0 = 0.f, a1 = 0.f, a2 = 0.f, a3 = 0.f, a4 = 0.f;
#pragma unroll 32
        for (int kk = 0; kk < 128; ++kk) { const int k = wave * 128 + kk; const float w = W[(size_t)k * 6144];
            a0 += sv[k] * w; a1 += sv[1024 + k] * w; a2 += sv[2048 + k] * w; a3 += sv[3072 + k] * w; a4 += sv[4096 + k] * w; }
        red[(wave * 5 + 0) * 64 + lane] = a0; red[(wave * 5 + 1) * 64 + lane] = a1; red[(wave * 5 + 2) * 64 + lane] = a2; red[(wave * 5 + 3) * 64 + lane] = a3; red[(wave * 5 + 4) * 64 + lane] = a4;
        __syncthreads();
        if (tid < 320) { const int j = tid >> 6, col = tid & 63; float s = 0.f;
#pragma unroll
            for (int w = 0; w < 8; ++w) s += red[(w * 5 + j) * 64 + col];
            MOD[(size_t)(l * 5 + j) * 6144 + cb * 64 + col] = s + mod_b[l * 6144 + cb * 64 + col]; }
        __syncthreads();
    }
    for (int i = blockIdx.x + G * tid; i < 512; i += G * 512) {
        const int p = i >> 3, f = i & 7;
        const double fr[8] = {1.0, 0.31622776601683794, 0.1, 0.031622776601683794, 0.01, 0.0031622776601683794, 0.001, 0.00031622776601683794};
        double th = 1.0;
#pragma unroll
        for (int q = 0; q < 8; ++q) th = (f == q) ? fr[q] : th;
        const double t2 = th * th; double cs = 1.0, sn = th, tc = 1.0, ts = th;
#pragma unroll
        for (int n = 1; n <= 12; ++n) { tc = -tc * t2 * (1.0 / (double)((2 * n - 1) * (2 * n))); ts = -ts * t2 * (1.0 / (double)((2 * n) * (2 * n + 1))); cs += tc; sn += ts; }
        double cr = 1.0, sr = 0.0, bc = cs, bs = sn;
#pragma unroll
        for (int bit = 0; bit < 6; ++bit) { if ((p >> bit) & 1) { const double nc = cr * bc - sr * bs, ns = sr * bc + cr * bs; cr = nc; sr = ns; }
            const double b2c = bc * bc - bs * bs, b2s = 2.0 * bc * bs; bc = b2c; bs = b2s; }
        float* R = (float*)(ws + WS_ROPE); R[i] = (float)cr; R[512 + i] = (float)sr;
    }
    for (int l = 0; l < 2; ++l) { u32x4* z = (u32x4*)(ws + WS_WIN + (size_t)l * NWIN * 1024 * 2 + (size_t)2592 * 1024 * 2);
        for (int i = blockIdx.x * 512 + tid; i < 224 * 1024 * 2 / 16; i += G * 512) z[i] = (u32x4){0u, 0u, 0u, 0u}; }
    __syncthreads();
    tr_range(P, ws, lds, wave, lane, blockIdx.x * 8 + wave, G * 8, IT_LAYER);
    __syncthreads();
}

template <int NR> DI void phase_norm(const void* srcL, int srcL_bf16, const float* srcC, int nrows, const float* g, const float* mod, int shoff, int scoff, bf16_t* U, const float* part, int npart, float* wb, int wave, int lane, int G) {
    const int gw = blockIdx.x * 8 + wave, NGW = G * 8;
#define NCOL(j) ((((j) >> 1) * 512) + 8 * lane + ((j) & 1) * 4)
    for (int row0 = gw; row0 < nrows; row0 += NR * NGW) {
        f32x4 v[NR][4]; float ss[NR];
#pragma unroll
        for (int q = 0; q < NR; ++q) { const int rq = row0 + q * NGW; const bool has = rq < nrows; const int row = has ? rq : row0;
            if (row < NLAT && srcL_bf16) { const bf16_t* sb = (const bf16_t*)srcL + (size_t)row * DM + 8 * lane;
#pragma unroll
                for (int gq = 0; gq < 2; ++gq) { const u32x4 w = *(const u32x4*)(sb + 512 * gq); v[q][2 * gq] = (f32x4){bflo(w.x), bfhi(w.x), bflo(w.y), bfhi(w.y)}; v[q][2 * gq + 1] = (f32x4){bflo(w.z), bfhi(w.z), bflo(w.w), bfhi(w.w)}; } }
            else { const float* src = row < NLAT ? (const float*)srcL + (size_t)row * DM : srcC + (size_t)(row - NLAT) * DM;
#pragma unroll
                for (int j = 0; j < 4; ++j) v[q][j] = *(const f32x4*)(src + NCOL(j)); }
            if (row >= NLAT && npart > 0) {
                for (int s = 0; s < npart; ++s) { const float* pr = part + ((size_t)s * NCTX + (row - NLAT)) * DM;
#pragma unroll
                    for (int j = 0; j < 4; ++j) v[q][j] += *(const f32x4*)(pr + NCOL(j)); }
                if (has) {
#pragma unroll
                    for (int j = 0; j < 4; ++j) *(f32x4*)(wb + (size_t)(row - NLAT) * DM + NCOL(j)) = v[q][j]; } } }
#pragma unroll
        for (int q = 0; q < NR; ++q) { ss[q] = 0.f;
#pragma unroll
            for (int j = 0; j < 4; ++j) ss[q] += (v[q][j].x * v[q][j].x + v[q][j].y * v[q][j].y) + (v[q][j].z * v[q][j].z + v[q][j].w * v[q][j].w); }
#pragma unroll
        for (int q = 0; q < NR; ++q) { const int row = row0 + q * NGW; if (row >= nrows) break;
            const float* md = mod + (row < NLAT ? (row >> 12) : 4) * 6144;
            const float r = rsqrtf(wave_sum(lane, ss[q]) * (1.f / DM) + 1e-6f);
#pragma unroll
            for (int gq = 0; gq < 2; ++gq) { u32x4 w;
#pragma unroll
                for (int hh = 0; hh < 2; ++hh) { const int j = 2 * gq + hh, col = NCOL(j);
                    const f32x4 gv = *(const f32x4*)(g + col), sc = *(const f32x4*)(md + scoff + col), sh = *(const f32x4*)(md + shoff + col);
                    const f32x4 o = v[q][j] * r * gv * (sc + 1.f) + sh;
                    if (hh == 0) { w.x = pk2(o.x, o.y); w.y = pk2(o.z, o.w); } else { w.z = pk2(o.x, o.y); w.w = pk2(o.z, o.w); } }
                *(u32x4*)(U + (size_t)row * DM + 512 * gq + 8 * lane) = w; } }
    }
#undef NCOL
}

struct EpiWin {
    static constexpr bool PERM = true, AFTER_DRAIN = false;
    unsigned char* ws; const float *qg, *kg, *gate_b;
    DI void operator()(const f32x4 (&acc)[2][2][4][2], const pg8::Unit& u, int wr, int wc, int fr, int fq) const {
        bf16_t *PM = (bf16_t*)(ws + WS_PM), *AQ = (bf16_t*)(ws + WS_AQ), *AK = (bf16_t*)(ws + WS_AK), *AVT = (bf16_t*)(ws + WS_AVT), *PC = (bf16_t*)(ws + WS_PC), *MKT = (bf16_t*)(ws + WS_MKT), *MVT = (bf16_t*)(ws + WS_MVT);
        float* GT = (float*)(ws + WS_GATE); const float* rope = (const float*)(ws + WS_ROPE);
        const int pn = u.pn, rowt = u.pm * 256; const bool lat = rowt < NLAT;
        const int b = lat ? (rowt >> 12) : ((rowt - NLAT) >> 8), pos0 = lat ? 256 + (rowt & 4095) : 0;
        const int rl0 = wr * 64 + fr, cl0 = wc * 32 + 8 * fq, lane = fr + 16 * fq;
        if (pn < 4 || (pn >= 7 && pn < 10)) {
            const float sc = (pn == 1) ? 0.125f : 1.f;
            if (pn != 2) {
            bf16_t* base = pn < 4 ? PM : PC; const int ldc = pn < 4 ? 1024 : 768, coff = pn < 4 ? pn * 256 : (pn - 7) * 256;
#pragma unroll
            for (int ai = 0; ai < 2; ++ai)
#pragma unroll
                for (int m = 0; m < 4; ++m) { const int row = rowt + 128 * ai + rl0 + 16 * m;
#pragma unroll
                    for (int bj = 0; bj < 2; ++bj) { const f32x4 v0 = acc[ai][bj][m][0] * sc, v1 = acc[ai][bj][m][1] * sc; u32x4 w; w.x = pk2(v0[0], v0[1]); w.y = pk2(v0[2], v0[3]); w.z = pk2(v1[0], v1[1]); w.w = pk2(v1[2], v1[3]);
                        *(u32x4*)(base + (size_t)row * ldc + coff + 128 * bj + cl0) = w; }
                    CFENCE(); }
            }
            if (pn == 1 || pn == 2) { bf16_t* T = (pn == 1 ? MKT : MVT) + (size_t)(b * 256 + (wc >> 1) * 64 + 32 * (wc & 1) + 8 * fq) * NPOS + pos0 + rl0;
#pragma unroll
                for (int ai = 0; ai < 2; ++ai)
#pragma unroll
                    for (int m = 0; m < 4; ++m) { bf16_t* Tp = T + 128 * ai + 16 * m;
#pragma unroll
                        for (int bj = 0; bj < 2; ++bj)
#pragma unroll
                            for (int n = 0; n < 2; ++n)
#pragma unroll
                                for (int i = 0; i < 4; ++i) Tp[(size_t)(128 * bj + 4 * n + i) * NPOS] = f2bf(acc[ai][bj][m][n][i] * sc);
                        CFENCE(); } }
        } else if (pn == 4 || pn == 5) {
            const float* g = pn == 4 ? qg : kg; const float osc = pn == 4 ? 0.17677669529663687f * 1.4426950408889634f : 1.f;
            float gv[8];
#pragma unroll
            for (int k = 0; k < 8; ++k) gv[k] = g[8 * fq + k];
#pragma unroll
            for (int ai = 0; ai < 2; ++ai)
#pragma unroll
                for (int m = 0; m < 4; ++m) { const int rl = 128 * ai + rl0 + 16 * m; const int t = (rowt & 4095) + rl; const int p = (fq >> 1) ? (t & 63) : (t >> 6);
#pragma unroll
                    for (int bj = 0; bj < 2; ++bj) { float y[8]; float ss = 0.f;
#pragma unroll
                        for (int k = 0; k < 8; ++k) { y[k] = acc[ai][bj][m][k >> 2][k & 3]; ss += y[k] * y[k]; }
                        ss += shx(lane, ss, 16); ss += shx(lane, ss, 32);
                        const float r = rsqrtf(ss * (1.f / 32.f) + 1e-6f);
#pragma unroll
                        for (int k = 0; k < 8; ++k) y[k] = y[k] * r * gv[k];
                        if (lat) {
#pragma unroll
                            for (int k = 0; k < 8; ++k) { const float cs = rope[p * 8 + k], sn = rope[512 + p * 8 + k]; const float pr = shx(lane, y[k], 16);
                                y[k] = (fq & 1) ? (y[k] * cs + pr * sn) : (y[k] * cs - pr * sn); } }
                        u32x4 w; w.x = pk2(y[0] * osc, y[1] * osc); w.y = pk2(y[2] * osc, y[3] * osc); w.z = pk2(y[4] * osc, y[5] * osc); w.w = pk2(y[6] * osc, y[7] * osc);
                        if (pn == 4) *(u32x4*)(AQ + (size_t)(rowt + rl) * 256 + 128 * bj + cl0) = w;
                        else *(u32x4*)(AK + ((size_t)b * NPOS + pos0 + rl) * 256 + 128 * bj + cl0) = w; }
                    CFENCE(); }
        } else if (pn == 6) {
            bf16_t* T = AVT + (size_t)(b * 256 + (wc >> 1) * 64 + 32 * (wc & 1) + 8 * fq) * NPOS + pos0 + rl0;
#pragma unroll
            for (int ai = 0; ai < 2; ++ai)
#pragma unroll
                for (int m = 0; m < 4; ++m) { bf16_t* Tp = T + 128 * ai + 16 * m;
#pragma unroll
                    for (int bj = 0; bj < 2; ++bj)
#pragma unroll
                        for (int n = 0; n < 2; ++n)
#pragma unroll
                            for (int i = 0; i < 4; ++i) Tp[(size_t)(128 * bj + 4 * n + i) * NPOS] = f2bf(acc[ai][bj][m][n][i]);
                    CFENCE(); }
        } else {
            if (wc == 0 && fq < 2) {
#pragma unroll
                for (int ai = 0; ai < 2; ++ai)
#pragma unroll
                    for (int m = 0; m < 4; ++m) { const int row = rowt + 128 * ai + rl0 + 16 * m; float o[8];
#pragma unroll
                        for (int k = 0; k < 8; ++k) { const int col = 8 * fq + k; float v = acc[ai][0][m][k >> 2][k & 3] + gate_b[col]; if ((col >> 2) & 1) v = logsigmoidf_(v); o[k] = v; }
                        *(f32x4*)(GT + (size_t)row * 16 + 8 * fq) = (f32x4){o[0], o[1], o[2], o[3]}; *(f32x4*)(GT + (size_t)row * 16 + 8 * fq + 4) = (f32x4){o[4], o[5], o[6], o[7]}; } }
        }
    }
};
struct EpiRes {
    static constexpr bool PERM = true, AFTER_DRAIN = false;
    const void* base; void* out; const float* gate; int base_bf16, out_bf16;
    DI void operator()(const f32x4 (&acc)[2][2][4][2], const pg8::Unit& u, int wr, int wc, int fr, int fq) const {
        const int rowt = u.pm * 256; const float* gv = gate + (rowt >> 12) * 6144; const int col0 = u.pn * 256 + wc * 32 + 8 * fq;
        f32x4 g4[2][2];
#pragma unroll
        for (int bj = 0; bj < 2; ++bj)
#pragma unroll
            for (int n = 0; n < 2; ++n) g4[bj][n] = *(const f32x4*)(gv + col0 + 128 * bj + 4 * n);
#pragma unroll
        for (int ai = 0; ai < 2; ++ai)
#pragma unroll
            for (int m = 0; m < 4; ++m) { const size_t off = (size_t)(rowt + 128 * ai + 64 * wr + 16 * m + fr) * DM + col0;
#pragma unroll
                for (int bj = 0; bj < 2; ++bj) { f32x4 b0, b1;
                    if (base_bf16) { const u32x4 w = *(const u32x4*)((const bf16_t*)base + off + 128 * bj); b0 = (f32x4){bflo(w.x), bfhi(w.x), bflo(w.y), bfhi(w.y)}; b1 = (f32x4){bflo(w.z), bfhi(w.z), bflo(w.w), bfhi(w.w)}; }
                    else { b0 = *(const f32x4*)((const float*)base + off + 128 * bj); b1 = *(const f32x4*)((const float*)base + off + 128 * bj + 4); }
                    const f32x4 h0 = b0 + g4[bj][0] * acc[ai][bj][m][0], h1 = b1 + g4[bj][1] * acc[ai][bj][m][1];
                    if (out_bf16) { u32x4 w; w.x = pk2(h0[0], h0[1]); w.y = pk2(h0[2], h0[3]); w.z = pk2(h1[0], h1[1]); w.w = pk2(h1[2], h1[3]); *(u32x4*)((bf16_t*)out + off + 128 * bj) = w; }
                    else { *(f32x4*)((float*)out + off + 128 * bj) = h0; *(f32x4*)((float*)out + off + 128 * bj + 4) = h1; } }
                CFENCE(); }
    }
};
struct EpiPart {
    static constexpr bool PERM = false, AFTER_DRAIN = false;
    float* part; const float* gate;
    DI void operator()(const f32x4 (&acc)[2][2][4][2], const pg8::Unit& u, int wr, int wc, int fr, int fq) const {
        const int col0 = (u.pn & 255) * 256 + wc * 32 + 4 * fq;
        float* os = part + (size_t)(u.pn >> 8) * NCTX * DM + (size_t)(u.pm * 256 + 64 * wr + fr) * DM + col0;
        f32x4 g4[2][2];
#pragma unroll
        for (int bj = 0; bj < 2; ++bj)
#pragma unroll
            for (int n = 0; n < 2; ++n) g4[bj][n] = *(const f32x4*)(gate + col0 + 128 * bj + 16 * n);
#pragma unroll
        for (int ai = 0; ai < 2; ++ai)
#pragma unroll
            for (int m = 0; m < 4; ++m) { float* o = os + (size_t)(128 * ai + 16 * m) * DM;
#pragma unroll
                for (int bj = 0; bj < 2; ++bj)
#pragma unroll
                    for (int n = 0; n < 2; ++n) *(f32x4*)(o + 128 * bj + 16 * n) = g4[bj][n] * acc[ai][bj][m][n];
                CFENCE(); }
    }
};
struct EpiSwiglu {
    static constexpr bool PERM = true, AFTER_DRAIN = false;
    bf16_t* HF;
    DI void operator()(const f32x4 (&acc)[2][2][4][2], const pg8::Unit& u, int wr, int wc, int fr, int fq) const {
        const int col = u.pn * 128 + wc * 32 + 8 * fq;
#pragma unroll
        for (int ai = 0; ai < 2; ++ai)
#pragma unroll
            for (int m = 0; m < 4; ++m) { const int row = u.pm * 256 + 128 * ai + 64 * wr + 16 * m + fr; float o[8];
#pragma unroll
                for (int k = 0; k < 8; ++k) { const float gg = acc[ai][0][m][k >> 2][k & 3], up = acc[ai][1][m][k >> 2][k & 3]; o[k] = gg * sigmoidf_(gg) * up; }
                u32x4 w; w.x = pk2(o[0], o[1]); w.y = pk2(o[2], o[3]); w.z = pk2(o[4], o[5]); w.w = pk2(o[6], o[7]);
                *(u32x4*)(HF + (size_t)row * DFF + col) = w; }
    }
};

DI int pos_row(int b, int pos) { return pos < CTXL ? NLAT + b * CTXL + pos : b * SEQ + (pos - CTXL); }

DI void mlstm_local(LAS unsigned char* lds, int wave, int lane, int item, const bf16_t* MKT, const bf16_t* MVT, const float* GT, float* CL, float* NL, float* ML, float* BT) {
    const int c = item % NCH, seq = item / NCH, dir = seq & 1, bh = seq >> 1, b = bh >> 2, hd = bh & 3, p0 = 64 * c;
    const float* gr = GT + (size_t)pos_row(b, p0 + lane) * 16 + dir * 8 + hd;
    const float iv = gr[0], fv = gr[4];
    float pre = fv;
#pragma unroll
    for (int o = 1; o < 64; o <<= 1) { const float t = shu(lane, pre, o); if (lane >= o) pre += t; }
    const float tot = bperm(pre, 63);
    const float bs = dir ? (tot - pre + fv) : pre;
    const float gs = tot - bs + iv;
    const float mloc = wave_max(lane, gs);
    const float es = __expf(gs - mloc);
    LAS float* ew = (LAS float*)(lds + wave * 2048);
    CFENCE(); ew[lane] = es; CFENCE();
    asm volatile("s_waitcnt lgkmcnt(0)" ::: "memory");
    const int r = lane & 31, h = lane >> 5;
    f32x16 acc[2][2];
#pragma unroll
    for (int a = 0; a < 2; ++a)
#pragma unroll
        for (int bb = 0; bb < 2; ++bb) acc[a][bb] = zero16();
    const bf16_t* vt = MVT + (size_t)(bh * 64) * NPOS + p0; const bf16_t* kt = MKT + (size_t)(bh * 64) * NPOS + p0;
#pragma unroll
    for (int ks = 0; ks < 4; ++ks) { const int off = 16 * ks + 8 * h;
        const f32x4 e0 = *(const LAS f32x4*)(ew + off), e1 = *(const LAS f32x4*)(ew + off + 4);
        bf16x8 af[2], bfv[2];
#pragma unroll
        for (int vb = 0; vb < 2; ++vb) af[vb] = *(const bf16x8*)(vt + (size_t)(32 * vb + r) * NPOS + off);
#pragma unroll
        for (int kb = 0; kb < 2; ++kb) { const u32x4 w = *(const u32x4*)(kt + (size_t)(32 * kb + r) * NPOS + off); u32x4 o;
            o.x = pk2(bflo(w.x) * e0[0], bfhi(w.x) * e0[1]); o.y = pk2(bflo(w.y) * e0[2], bfhi(w.y) * e0[3]); o.z = pk2(bflo(w.z) * e1[0], bfhi(w.z) * e1[1]); o.w = pk2(bflo(w.w) * e1[2], bfhi(w.w) * e1[3]);
            bfv[kb] = __builtin_bit_cast(bf16x8, o); }
#pragma unroll
        for (int vb = 0; vb < 2; ++vb)
#pragma unroll
            for (int kb = 0; kb < 2; ++kb) acc[vb][kb] = MFMA32(af[vb], bfv[kb], acc[vb][kb]);
    }
    float* cl = CL + (size_t)item * 4096;
#pragma unroll
    for (int vb = 0; vb < 2; ++vb)
#pragma unroll
        for (int kb = 0; kb < 2; ++kb)
#pragma unroll
            for (int i = 0; i < 16; ++i) cl[(32 * vb + crow(i, h)) * 64 + 32 * kb + r] = acc[vb][kb][i];
    float nacc = 0.f; const bf16_t* krow = kt + (size_t)lane * NPOS;
#pragma unroll
    for (int q = 0; q < 8; ++q) { const u32x4 w = *(const u32x4*)(krow + 8 * q); const f32x4 e0 = *(const LAS f32x4*)(ew + 8 * q), e1 = *(const LAS f32x4*)(ew + 8 * q + 4);
        nacc += bflo(w.x) * e0[0] + bfhi(w.x) * e0[1] + bflo(w.y) * e0[2] + bfhi(w.y) * e0[3] + bflo(w.z) * e1[0] + bfhi(w.z) * e1[1] + bflo(w.w) * e1[2] + bfhi(w.w) * e1[3]; }
    NL[(size_t)item * 64 + lane] = nacc;
    if (lane == 0) { ML[item] = mloc; BT[item] = tot; }
    asm volatile("s_waitcnt lgkmcnt(0)" ::: "memory"); CFENCE();
}

DI void mlstm_scan(LAS unsigned char* lds, int tid, int item, const float* CL, const float* NL, const float* ML, const float* BT, bf16_t* CS, float* NS, float* MS) {
    const int seq = item >> 3, part = item & 7, dir = seq & 1, e = part * 512 + tid;
    LAS float* sc = (LAS float*)lds;
    LAS float* co = sc + 2 * NCH;
    __syncthreads();
    if (tid < NCH) { const int c = dir ? (tid < 4 ? 3 - tid : 71 - tid) : tid; sc[2 * tid] = BT[seq * NCH + c]; sc[2 * tid + 1] = ML[seq * NCH + c]; }
    __syncthreads();
    if (tid < 64) {
        const int lane = tid; const float bt = sc[2 * lane], ml = sc[2 * lane + 1]; float A = bt, C = ml;
#pragma unroll
        for (int o = 1; o < 64; o <<= 1) { const float Ap = shu(lane, A, o), Cp = shu(lane, C, o); if (lane >= o) { C = fmaxf(Cp + A, C); A = Ap + A; } }
        const float mnext = fmaxf(A, C);
        const float mprev = shu(lane, mnext, 1); const float m = lane == 0 ? 0.f : mprev;
        co[2 * lane] = __expf(bt + m - mnext); co[2 * lane + 1] = __expf(ml - mnext);
        { const int c = dir ? (lane < 4 ? 3 - lane : 71 - lane) : lane; if (part == 0) MS[seq * NCH + c] = m; }
        float mm = bperm(mnext, 63);
        if (lane == 0) { for (int j = 64; j < NCH; ++j) { const int c = dir ? 71 - j : j; const float b2 = sc[2 * j], l2 = sc[2 * j + 1];
            if (part == 0) MS[seq * NCH + c] = mm;
            const float mn = fmaxf(b2 + mm, l2); co[2 * j] = __expf(b2 + mm - mn); co[2 * j + 1] = __expf(l2 - mn); mm = mn; } } }
    float cl[NCH];
#pragma unroll
    for (int j = 0; j < NCH; ++j) { const int c = dir ? (j < 4 ? 3 - j : 71 - j) : j; cl[j] = CL[(size_t)(seq * NCH + c) * 4096 + e]; }
    __syncthreads();
    float C = 0.f, n = 0.f; const bool don = (part == 0 && tid < 64);
#pragma unroll
    for (int j = 0; j < NCH; ++j) { const int c = dir ? (j < 4 ? 3 - j : 71 - j) : j; const int idx = seq * NCH + c;
        CS[(size_t)idx * 4096 + e] = f2bf(C);
        if (don) NS[(size_t)idx * 64 + tid] = n;
        const float a = co[2 * j], bb = co[2 * j + 1];
        C = a * C + bb * cl[j]; if (don) n = a * n + bb * NL[(size_t)idx * 64 + tid]; }
}

DI void mlstm_out(LAS unsigned char* lds, int wave, int lane, int item, const bf16_t* PM, const bf16_t* MVT, const float* GT, const bf16_t* CS, const float* NS, const float* MS, const float* ng, bf16_t* Y) {
    const int th = item & 1, c = (item >> 1) % NCH, bh = (item >> 1) / NCH, b = bh >> 2, hd = bh & 3, p0 = 64 * c;
    const int r = lane & 31, h = lane >> 5, tl = 32 * th + r;
    LAS float* T0 = (LAS float*)(lds + wave * 2048);
    const int rowbase = pos_row(b, p0);
    const bf16_t* qp = PM + (size_t)(rowbase + tl) * 1024 + hd * 64 + 8 * h;
    bf16x8 qf[4];
#pragma unroll
    for (int ks = 0; ks < 4; ++ks) qf[ks] = *(const bf16x8*)(qp + 16 * ks);
    f32x16 St[2];
#pragma unroll
    for (int sb = 0; sb < 2; ++sb) { St[sb] = zero16(); const bf16_t* kp = PM + (size_t)(rowbase + 32 * sb + pi32(r)) * 1024 + 256 + hd * 64 + 8 * h;
#pragma unroll
        for (int ks = 0; ks < 4; ++ks) { const bf16x8 kf = *(const bf16x8*)(kp + 16 * ks); St[sb] = MFMA32(kf, qf[ks], St[sb]); } }
    __builtin_amdgcn_sched_barrier(0); CFENCE();
    f32x16 htot[2]; htot[0] = zero16(); htot[1] = zero16();
    const bf16_t* vt = MVT + (size_t)(bh * 64) * NPOS + p0;
#pragma nounroll
    for (int d = 0; d < 2; ++d) {
        LAS float* T = T0;
        int tlo = tl, ho = h; asm volatile("" : "+v"(tlo), "+v"(ho));
        const int idx = (bh * 2 + d) * NCH + c; const bf16_t* cs = CS + (size_t)idx * 4096;
        float bmine, mmine, einter, thr;
        bf16x8 cfp[4][2];
#pragma unroll
        for (int ks = 0; ks < 4; ++ks)
#pragma unroll
            for (int vb = 0; vb < 2; ++vb) cfp[ks][vb] = *(const bf16x8*)(cs + (32 * vb + r) * 64 + 16 * ks + 8 * ho);
        {
            const float* gr = GT + (size_t)(rowbase + lane) * 16 + d * 8 + hd; const float iv = gr[0], fv = gr[4];
            float pre = fv;
#pragma unroll
            for (int o = 1; o < 64; o <<= 1) { const float t = shu(lane, pre, o); if (lane >= o) pre += t; }
            const float tot = bperm(pre, 63);
            const float bs = d ? (tot - pre + fv) : pre;
            const float ws_ = iv - bs;
            float a = ws_;
#pragma unroll
            for (int o = 1; o < 64; o <<= 1) { const float tu = shu(lane, a, o), td = shd(lane, a, o); const float t = d ? td : tu; const bool ok = d ? (lane + o < 64) : (lane >= o); if (ok) a = fmaxf(a, t); }
            const float mst = MS[idx];
            const float mt = fmaxf(bs + mst, bs + a);
            asm volatile("s_waitcnt lgkmcnt(0)" ::: "memory");
            T[lane] = ws_; T[64 + lane] = NS[(size_t)idx * 64 + lane]; T[128 + lane] = bs; T[192 + lane] = mt;
            asm volatile("s_waitcnt lgkmcnt(0)" ::: "memory");
            bmine = T[128 + tl]; mmine = T[192 + tl];
            einter = __expf(bmine + mst - mmine); thr = __expf(-mmine);
        }
        __builtin_amdgcn_sched_barrier(0); CFENCE();
        f32x16 Hn[2]; Hn[0] = zero16(); Hn[1] = zero16(); float nq = 0.f;
#pragma unroll
        for (int ks = 0; ks < 4; ++ks) {
#pragma unroll
            for (int vb = 0; vb < 2; ++vb) Hn[vb] = MFMA32(cfp[ks][vb], qf[ks], Hn[vb]);
            const f32x4 n0 = *(const LAS f32x4*)(T + 64 + 16 * ks + 8 * h), n1 = *(const LAS f32x4*)(T + 64 + 16 * ks + 8 * h + 4);
            u32x4 qw = __builtin_bit_cast(u32x4, qf[ks]); asm volatile("" : "+v"(qw));
            nq += bflo(qw.x) * n0[0] + bfhi(qw.x) * n0[1] + bflo(qw.y) * n0[2] + bfhi(qw.y) * n0[3] + bflo(qw.z) * n1[0] + bfhi(qw.z) * n1[1] + bflo(qw.w) * n1[2] + bfhi(qw.w) * n1[3]; }
        nq += shx(lane, nq, 32);
#pragma unroll
        for (int vb = 0; vb < 2; ++vb)
#pragma unroll
            for (int i = 0; i < 16; ++i) Hn[vb][i] *= einter;
        __builtin_amdgcn_sched_barrier(0); CFENCE();
        const float bm = bmine - mmine; float dsum = 0.f;
#pragma unroll
        for (int sb = 0; sb < 2; ++sb) {
            bf16x8 pf[2];
#pragma unroll
            for (int ss = 0; ss < 2; ++ss) { const int s0 = 32 * sb + 16 * ss + 8 * h;
                const f32x4 w0 = *(const LAS f32x4*)(T + s0), w1 = *(const LAS f32x4*)(T + s0 + 4); float pv[8];
#pragma unroll
                for (int j = 0; j < 8; ++j) { const int s = s0 + j; const float wv = j < 4 ? w0[j & 3] : w1[j & 3]; const bool ok = d ? (s >= tlo) : (s <= tlo);
                    const float x = ok ? __expf(bm + wv) * St[sb][8 * ss + j] : 0.f; pv[j] = x; dsum += x; }
                u32x4 o; o.x = pk2(pv[0], pv[1]); o.y = pk2(pv[2], pv[3]); o.z = pk2(pv[4], pv[5]); o.w = pk2(pv[6], pv[7]); pf[ss] = __builtin_bit_cast(bf16x8, o); }
            CFENCE();
#pragma unroll
            for (int ss = 0; ss < 2; ++ss)
#pragma unroll
                for (int vb = 0; vb < 2; ++vb) { const bf16x8 vf = *(const bf16x8*)(vt + (size_t)(32 * vb + r) * NPOS + 32 * sb + 16 * ss + 8 * ho); Hn[vb] = MFMA32(vf, pf[ss], Hn[vb]); }
        }
        __builtin_amdgcn_sched_barrier(0); CFENCE();
        dsum += shx(lane, dsum, 32);
        const float den = einter * nq + dsum; const float inv = 1.f / fmaxf(fabsf(den), thr);
#pragma unroll
        for (int vb = 0; vb < 2; ++vb)
#pragma unroll
            for (int i = 0; i < 16; ++i) htot[vb][i] += Hn[vb][i] * inv;
    }
    float ss = 0.f;
#pragma unroll
    for (int vb = 0; vb < 2; ++vb)
#pragma unroll
        for (int i = 0; i < 16; ++i) ss += htot[vb][i] * htot[vb][i];
    ss += shx(lane, ss, 32);
    const float rinv = rsqrtf(ss * (1.f / 64.f) + 1e-6f);
    const size_t row = (size_t)(rowbase + tl);
#pragma unroll
    for (int vb = 0; vb < 2; ++vb)
#pragma unroll
        for (int q = 0; q < 4; ++q) { const int v0 = 32 * vb + 8 * q + 4 * h;
            const u32x2 ow = *(const u32x2*)(PM + row * 1024 + 768 + hd * 64 + v0); const f32x4 g4 = *(const f32x4*)(ng + v0);
            const float o0 = sigmoidf_(bflo(ow.x)) * htot[vb][4 * q + 0] * rinv * g4[0], o1 = sigmoidf_(bfhi(ow.x)) * htot[vb][4 * q + 1] * rinv * g4[1];
            const float o2 = sigmoidf_(bflo(ow.y)) * htot[vb][4 * q + 2] * rinv * g4[2], o3 = sigmoidf_(bfhi(ow.y)) * htot[vb][4 * q + 3] * rinv * g4[3];
            u32x2 w; w.x = pk2(o0, o1); w.y = pk2(o2, o3); *(u32x2*)(Y + row * 1024 + hd * 64 + v0) = w; }
    asm volatile("s_waitcnt lgkmcnt(0)" ::: "memory"); CFENCE();
}

DI void mixer_tile(LAS unsigned char* lds, int tid, int wave, int lane, int tile, const bf16_t* PC, const bf16_t* PoolWT, const float* pool_scale, const float* dw_b,
                   const float* ln_g, const float* ln_b, const bf16_t* PwT, bf16_t* Y) {
    int b, t0, L, seqrow0;
    if (tile < 256) { b = tile >> 6; t0 = (tile & 63) * 64; L = SEQ; seqrow0 = b * SEQ; } else { const int ct = tile - 256; b = ct >> 2; t0 = (ct & 3) * 64; L = CTXL; seqrow0 = NLAT + b * CTXL; }
    const int row0 = seqrow0 + t0;
    LAS unsigned char* A = lds; LAS unsigned char* zt = lds + 49664; LAS float* dww = (LAS float*)(lds + 83456);
    const int r = lane & 31, h = lane >> 5;
#pragma unroll
    for (int q = 0; q < 5; ++q) { const int i = tid + 512 * q, rr = i >> 5, pc = i & 31, t = t0 - 8 + rr; u32x4 v = (u32x4){0u, 0u, 0u, 0u};
        if (t >= 0 && t < L) v = *(const u32x4*)(PC + (size_t)(seqrow0 + t) * 768 + pc * 8);
        *(LAS u32x4*)(A + rr * 528 + pc * 16) = v; }
    __syncthreads();
    { const int ch = tid & 255, tb0 = (tid >> 8) * 32, gi = ch >> 6, w = 2 << gi, wl = w >> 1, wrt = w - 1 - wl;
        const LAS unsigned char* col = A + ch * 2;
        float s = 0.f;
        for (int q = -wl; q <= wrt; ++q) s += bf2f(*(const LAS bf16_t*)(col + (tb0 + q + 8) * 528));
#pragma unroll 4
        for (int tt = 0; tt < 32; ++tt) { const int tloc = tb0 + tt, t = t0 + tloc; const int cnt = min(t + wrt, L - 1) - max(t - wl, 0) + 1;
            const float self = bf2f(*(const LAS bf16_t*)(col + (tloc + 8) * 528));
            *(LAS bf16_t*)(zt + tloc * 528 + ch * 2) = f2bf(s * __builtin_amdgcn_rcpf((float)cnt) - self);
            s += bf2f(*(const LAS bf16_t*)(col + (tloc + 9 + wrt) * 528)) - bf2f(*(const LAS bf16_t*)(col + (tloc + 8 - wl) * 528)); } }
    __syncthreads();
    {
#pragma unroll
        for (int q = 0; q < 6; ++q) { const int i = tid + 512 * q; if (i < 94 * 32) { const int rr = i >> 5, pc = i & 31, t = t0 - 15 + rr; u32x4 o = (u32x4){0u, 0u, 0u, 0u};
            if (t >= 0 && t < L) { const bf16_t* pr = PC + (size_t)(seqrow0 + t) * 768 + pc * 8; const u32x4 a8 = *(const u32x4*)(pr + 256), g8 = *(const u32x4*)(pr + 512);
                o.x = pk2(bflo(a8.x) * sigmoidf_(bflo(g8.x)), bfhi(a8.x) * sigmoidf_(bfhi(g8.x))); o.y = pk2(bflo(a8.y) * sigmoidf_(bflo(g8.y)), bfhi(a8.y) * sigmoidf_(bfhi(g8.y)));
                o.z = pk2(bflo(a8.z) * sigmoidf_(bflo(g8.z)), bfhi(a8.z) * sigmoidf_(bfhi(g8.z))); o.w = pk2(bflo(a8.w) * sigmoidf_(bflo(g8.w)), bfhi(a8.w) * sigmoidf_(bfhi(g8.w))); }
            *(LAS u32x4*)(A + rr * 528 + pc * 16) = o; } }
    }
    {
        const int gi = wave >> 1, dh = wave & 1; bf16x8 af[4];
#pragma unroll
        for (int ks = 0; ks < 4; ++ks) af[ks] = *(const bf16x8*)(PoolWT + (size_t)(gi * 64 + 32 * dh + r) * 64 + 16 * ks + 8 * h);
#pragma unroll
        for (int tb = 0; tb < 2; ++tb) { f32x16 acc = zero16();
#pragma unroll
            for (int ks = 0; ks < 4; ++ks) { const bf16x8 bv = *(const LAS bf16x8*)(zt + (32 * tb + r) * 528 + (gi * 64 + 16 * ks + 8 * h) * 2); acc = MFMA32(af[ks], bv, acc); }
#pragma unroll
            for (int q = 0; q < 4; ++q) { const int d0 = gi * 64 + 32 * dh + 8 * q + 4 * h; const f32x4 ps = *(const f32x4*)(pool_scale + d0);
                u32x2 w; w.x = pk2(acc[4 * q] * ps[0], acc[4 * q + 1] * ps[1]); w.y = pk2(acc[4 * q + 2] * ps[2], acc[4 * q + 3] * ps[3]);
                *(u32x2*)(Y + (size_t)(row0 + 32 * tb + r) * 1024 + 512 + d0) = w; } }
    }
    __syncthreads();
    {
        const f32x4 db = *(const f32x4*)(dw_b + 4 * lane), lg = *(const f32x4*)(ln_g + 4 * lane), lb = *(const f32x4*)(ln_b + 4 * lane);
        for (int q = 0; q < 8; ++q) { const int tloc = wave + 8 * q; f32x4 a = db;
#pragma unroll
            for (int k = 0; k < 31; ++k) { const u32x2 gw = *(const LAS u32x2*)(A + (tloc + k) * 528 + lane * 8); const f32x4 wv = *(const LAS f32x4*)(dww + k * 256 + 4 * lane);
                a[0] += bflo(gw.x) * wv[0]; a[1] += bfhi(gw.x) * wv[1]; a[2] += bflo(gw.y) * wv[2]; a[3] += bfhi(gw.y) * wv[3]; }
            const float mean = wave_sum(lane, (a[0] + a[1]) + (a[2] + a[3])) * (1.f / 256.f); const f32x4 dv = a - mean;
            const float var = wave_sum(lane, (dv[0] * dv[0] + dv[1] * dv[1]) + (dv[2] * dv[2] + dv[3] * dv[3])) * (1.f / 256.f); const float rs = rsqrtf(var + 1e-5f);
            const f32x4 xn = dv * rs * lg + lb; u32x2 w; w.x = pk2(xn[0] * sigmoidf_(xn[0]), xn[1] * sigmoidf_(xn[1])); w.y = pk2(xn[2] * sigmoidf_(xn[2]), xn[3] * sigmoidf_(xn[3]));
            *(LAS u32x2*)(zt + tloc * 528 + lane * 8) = w; }
    }
    __syncthreads();
    {
        f32x16 acc[2]; acc[0] = zero16(); acc[1] = zero16();
#pragma unroll 4
        for (int ks = 0; ks < 16; ++ks) { const bf16x8 af = *(const bf16x8*)(PwT + (size_t)(32 * wave + r) * 256 + 16 * ks + 8 * h);
#pragma unroll
            for (int tb = 0; tb < 2; ++tb) { const bf16x8 bv = *(const LAS bf16x8*)(zt + (32 * tb + r) * 528 + (16 * ks + 8 * h) * 2); acc[tb] = MFMA32(af, bv, acc[tb]); } }
#pragma unroll
        for (int tb = 0; tb < 2; ++tb)
#pragma unroll
            for (int q = 0; q < 4; ++q) { const int d0 = 32 * wave + 8 * q + 4 * h; u32x2 w; w.x = pk2(acc[tb][4 * q], acc[tb][4 * q + 1]); w.y = pk2(acc[tb][4 * q + 2], acc[tb][4 * q + 3]);
                *(u32x2*)(Y + (size_t)(row0 + 32 * tb + r) * 1024 + 768 + d0) = w; }
    }
    __syncthreads();
}

template <bool SHIFT> DI void attn_unit(LAS unsigned char* lds, int tid, int wave, int lane, int b, int hd, int qrow0, int ntiles, float lam, float negshift, float outscale,
                  const bf16_t* AQ, const bf16_t* AK, const bf16_t* AVT, const float* subg, bf16_t* Y) {
    const int r = lane & 31, h = lane >> 5; const size_t qrow = (size_t)qrow0 + wave * 32 + r;
    bf16x8 qf[2][2];
#pragma unroll
    for (int m = 0; m < 2; ++m)
#pragma unroll
        for (int ks = 0; ks < 2; ++ks) qf[m][ks] = *(const bf16x8*)(AQ + qrow * 256 + hd * 64 + m * 32 + 16 * ks + 8 * h);
    f32x16 O[2][2];
#pragma unroll
    for (int m = 0; m < 2; ++m)
#pragma unroll
        for (int eb = 0; eb < 2; ++eb) O[m][eb] = zero16();
    float lsum[2] = {0.f, 0.f};
    const int kkey = tid >> 3, piece = tid & 7;
    const bf16_t* kg = AK + ((size_t)b * NPOS + kkey) * 256 + hd * 64 + piece * 8;
    const bf16_t* vg = AVT + ((size_t)((b * 4 + hd) * 64 + kkey)) * NPOS + piece * 8;
    const int stoff = kkey * 144 + piece * 16;
    u32x4 kreg = *(const u32x4*)kg, vreg = *(const u32x4*)vg;
    *(LAS u32x4*)(lds + stoff) = kreg; *(LAS u32x4*)(lds + 9216 + stoff) = vreg;
    __syncthreads();
    const int koff = pi32(r) * 144 + 16 * h, voff = r * 144 + 16 * h;
    for (int tile = 0; tile < ntiles; ++tile) {
        const int cur = tile & 1; const bool more = tile + 1 < ntiles;
        if (more) { kreg = *(const u32x4*)(kg + (size_t)(tile + 1) * 64 * 256); vreg = *(const u32x4*)(vg + (size_t)(tile + 1) * 64); }
        LAS unsigned char* Kt = lds + cur * 18432; LAS unsigned char* Vt = Kt + 9216;
        f32x16 s[2][2];
#pragma unroll
        for (int kb = 0; kb < 2; ++kb)
#pragma unroll
            for (int m = 0; m < 2; ++m)
#pragma unroll
                for (int i = 0; i < 16; ++i) s[kb][m][i] = SHIFT ? negshift : 0.f;
#pragma unroll
        for (int ks = 0; ks < 2; ++ks)
#pragma unroll
            for (int kb = 0; kb < 2; ++kb)
#pragma unroll
                for (int m = 0; m < 2; ++m) { const bf16x8 kf = *(const LAS bf16x8*)(Kt + kb * 32 * 144 + koff + (m * 32 + 16 * ks) * 2); s[kb][m] = MFMA32(kf, qf[m][ks], s[kb][m]); }
#pragma unroll
        for (int kb = 0; kb < 2; ++kb) {
            bf16x8 pf[2][2];
#pragma unroll
            for (int m = 0; m < 2; ++m) { float p[16];
#pragma unroll
                for (int i = 0; i < 16; ++i) { p[i] = __builtin_amdgcn_exp2f(s[kb][m][i]); lsum[m] += p[i]; }
#pragma unroll
                for (int ss = 0; ss < 2; ++ss) { u32x4 o; o.x = pk2(p[8 * ss], p[8 * ss + 1]); o.y = pk2(p[8 * ss + 2], p[8 * ss + 3]); o.z = pk2(p[8 * ss + 4], p[8 * ss + 5]); o.w = pk2(p[8 * ss + 6], p[8 * ss + 7]);
                    pf[m][ss] = __builtin_bit_cast(bf16x8, o); } }
#pragma unroll
            for (int eb = 0; eb < 2; ++eb)
#pragma unroll
                for (int ss = 0; ss < 2; ++ss) { const bf16x8 vf = *(const LAS bf16x8*)(Vt + eb * 32 * 144 + voff + (32 * kb + 16 * ss) * 2);
                    O[0][eb] = MFMA32(vf, pf[0][ss], O[0][eb]); O[1][eb] = MFMA32(vf, pf[1][ss], O[1][eb]); }
        }
        if (more) { LAS unsigned char* nx = lds + (cur ^ 1) * 18432; *(LAS u32x4*)(nx + stoff) = kreg; *(LAS u32x4*)(nx + 9216 + stoff) = vreg; }
        __syncthreads();
    }
    const float l0 = lsum[0] + shx(lane, lsum[0], 32), l1 = lsum[1] + shx(lane, lsum[1], 32);
    const float a0 = 1.f / l0, a1 = lam / l1; float ss = 0.f;
#pragma unroll
    for (int eb = 0; eb < 2; ++eb)
#pragma unroll
        for (int i = 0; i < 16; ++i) { const float o = O[0][eb][i] * a0 - O[1][eb][i] * a1; O[0][eb][i] = o; ss += o * o; }
    ss += shx(lane, ss, 32);
    const float rinv = rsqrtf(ss * (1.f / 64.f) + 1e-6f) * outscale;
#pragma unroll
    for (int eb = 0; eb < 2; ++eb)
#pragma unroll
        for (int q = 0; q < 4; ++q) { const int e0 = 32 * eb + 8 * q + 4 * h; const f32x4 g4 = *(const f32x4*)(subg + e0);
            u32x2 w; w.x = pk2(O[0][eb][4 * q] * rinv * g4[0], O[0][eb][4 * q + 1] * rinv * g4[1]); w.y = pk2(O[0][eb][4 * q + 2] * rinv * g4[2], O[0][eb][4 * q + 3] * rinv * g4[3]);
            *(u32x2*)(Y + qrow * 1024 + 256 + hd * 64 + e0) = w; }
}

#define XB_TMO      128
#define XB_XCNT(j)  (256  + 64 * (j))
#define XB_XSUB(j)  (1280 + 64 * (j))
#define XB_XGEN(j)  (2304 + 64 * (j))
#define XB_TOP      3328
#define XB_TOPGEN   3392
#define XCD_BAR_WORDS 3456
#define XB_SPIN_CAP (1u << 18)

__device__ __forceinline__ unsigned xb_ld(unsigned* p)              { return __hip_atomic_load(p, __ATOMIC_RELAXED, __HIP_MEMORY_SCOPE_AGENT); }
__device__ __forceinline__ unsigned xb_add(unsigned* p, unsigned v) { return __hip_atomic_fetch_add(p, v, __ATOMIC_RELAXED, __HIP_MEMORY_SCOPE_AGENT); }
__device__ __forceinline__ unsigned xb_xcc_id() { return (unsigned)__builtin_amdgcn_s_getreg((3 << 11) | 20) & 0xFu; }
#define XB_SPIN(cond, bar) do { unsigned _sp = 0; while (cond) { __builtin_amdgcn_s_sleep(1); \
    if ((++_sp & 255u) == 0u) { if (xb_ld(&(bar)[XB_TMO])) break; if (_sp > XB_SPIN_CAP) { atomicAdd(&(bar)[XB_TMO], 1u); break; } } } } while (0)

struct XcdBarrier {
    unsigned* bar; unsigned x;
    volatile LAS unsigned* st;
};

__device__ __forceinline__ XcdBarrier xcd_barrier_post(unsigned* bar, volatile LAS unsigned* st) {
    XcdBarrier b; b.bar = bar; b.x = xb_xcc_id(); b.st = st;
    if (threadIdx.x == 0) (void)xb_add(&bar[XB_XCNT(b.x)], 1u);
    return b;
}
__device__ __forceinline__ void xcd_barrier_complete(unsigned* bar, unsigned x, unsigned& nloc, unsigned& nx) {
    const unsigned G = gridDim.x * gridDim.y * gridDim.z;
    unsigned sum, cnt, mine, sp = 0u;
    for (;;) {
        sum = 0u; cnt = 0u; mine = 0u;
#pragma unroll
        for (unsigned j = 0; j < 16; ++j) { const unsigned c = xb_ld(&bar[XB_XCNT(j)]); sum += c; cnt += (c > 0u) ? 1u : 0u; mine = (j == x) ? c : mine; }
        if (sum == G) break;
        __builtin_amdgcn_s_sleep(1);
        if ((++sp & 255u) == 0u) { if (xb_ld(&bar[XB_TMO])) break; if (sp > XB_SPIN_CAP) { atomicAdd(&bar[XB_TMO], 1u); break; } }
    }
    nloc = mine > 0u ? mine : 1u; nx = cnt > 0u ? cnt : 1u;
}

__device__ __forceinline__ void xcd_barrier(const XcdBarrier& b, const int tid_) {
    asm volatile("s_waitcnt vmcnt(0)" ::: "memory");
    __syncthreads();
    if (tid_ == 0) {
        unsigned* bar = b.bar;
        __builtin_amdgcn_s_waitcnt(0);
        unsigned nloc = b.st[0], nx = b.st[1];
        if (nloc == 0u) { xcd_barrier_complete(bar, b.x, nloc, nx); b.st[0] = nloc; b.st[1] = nx; }
        const unsigned old = xb_add(&bar[XB_XSUB(b.x)], 1u);
        const unsigned gen = old / nloc;
        if (old + 1u == (gen + 1u) * nloc) {
            __builtin_amdgcn_fence(__ATOMIC_RELEASE, "agent");
            asm volatile("s_waitcnt vmcnt(0)" ::: "memory");
            const unsigned og = xb_add(&bar[XB_TOP], 1u);
            const unsigned tg = og / nx;
            if (og + 1u == (tg + 1u) * nx) xb_add(&bar[XB_TOPGEN], 1u);
            else XB_SPIN(xb_ld(&bar[XB_TOPGEN]) == tg, bar);
            __builtin_amdgcn_fence(__ATOMIC_ACQUIRE, "agent");
            xb_add(&bar[XB_XGEN(b.x)], 1u);
            asm volatile("s_waitcnt vmcnt(0)" ::: "memory");
        } else {
            XB_SPIN(xb_ld(&bar[XB_XGEN(b.x)]) == gen, bar);
            __builtin_amdgcn_fence(__ATOMIC_ACQUIRE, "agent");
            asm volatile("s_waitcnt vmcnt(0)" ::: "memory");
        }
    }
    __syncthreads();
}

__device__ __forceinline__ void xcd_arrive(unsigned* sb, volatile LAS unsigned* st, const int tid_) {
    asm volatile("s_waitcnt vmcnt(0)" ::: "memory");
    __syncthreads();
    if (tid_ == 0) {
        const unsigned x = xb_xcc_id(); const unsigned nloc = st[0], nx = st[1];
        const unsigned old = xb_add(&sb[XB_XSUB(x)], 1u); const unsigned gen = old / nloc;
        if (old + 1u == (gen + 1u) * nloc) {
            __builtin_amdgcn_fence(__ATOMIC_RELEASE, "agent"); asm volatile("s_waitcnt vmcnt(0)" ::: "memory");
            const unsigned og = xb_add(&sb[XB_TOP], 1u);
            if (og + 1u == (og / nx + 1u) * nx) xb_add(&sb[XB_TOPGEN], 1u);
        }
    }
}
__device__ __forceinline__ void xcd_wait(unsigned* sb, unsigned target, const int tid_) {
    if (tid_ == 0) { unsigned spins = 0; while (xb_ld(&sb[XB_TOPGEN]) < target) { __builtin_amdgcn_s_sleep(1); if (++spins > (1u << 22)) break; }
        __builtin_amdgcn_fence(__ATOMIC_ACQUIRE, "agent"); asm volatile("s_waitcnt vmcnt(0)" ::: "memory"); }
    __syncthreads();
}

__global__ void __launch_bounds__(512, 2) mega(Params P) {
    extern __shared__ __attribute__((aligned(16))) unsigned char lds_raw[];
    LAS unsigned char* lds = (LAS unsigned char*)lds_raw;
    const int G = gridDim.x;
    const int wave_s = __builtin_amdgcn_readfirstlane(threadIdx.x >> 6);
#define PH_BEGIN() int tid; asm volatile("v_mbcnt_lo_u32_b32 %0, -1, 0\n\tv_mbcnt_hi_u32_b32 %0, -1, %0" : "=v"(tid)); tid += wave_s * 64; const int lane = tid & 63, wave = wave_s; (void)lane; (void)wave; \
    __attribute__((address_space(1))) unsigned char* wsg_ = (__attribute__((address_space(1))) unsigned char*)P.ws; asm volatile("" : "+s"(wsg_)); unsigned char* ws = (unsigned char*)wsg_; int l = lq_; asm volatile("" : "+s"(l)); const bool last = (l == 1); (void)last; const float* mod = (const float*)(ws + WS_MOD) + (size_t)l * 5 * 6144; (void)mod
#define WSP(T, off) ((T*)(ws + (off)))
    const int lo = P.ph_lo, hi = P.ph_hi;
#define IN(k) (lo <= (k) && (k) < hi)
#if MK_COOP
#define SEAM(k) do { if (IN(k) && IN((k) + 1)) { __attribute__((address_space(1))) unsigned char* wsbg_ = (__attribute__((address_space(1))) unsigned char*)P.ws; asm volatile("" : "+s"(wsbg_)); unsigned char* wsb_ = (unsigned char*)wsbg_; XcdBarrier bar_; bar_.bar = (unsigned*)(wsb_ + WS_CTL); bar_.x = xb_xcc_id(); bar_.st = (volatile LAS unsigned*)(lds + 131072) + 8; int tb_; asm volatile("v_mbcnt_lo_u32_b32 %0, -1, 0\n\tv_mbcnt_hi_u32_b32 %0, -1, %0" : "=v"(tb_)); tb_ += wave_s * 64; for (int rs_ = 0; rs_ < REP_SYNC; ++rs_) xcd_barrier(bar_, tb_); } } while (0)
#else
#define SEAM(k) do { } while (0)
#endif
    {
        volatile LAS unsigned* MISC = (volatile LAS unsigned*)(lds + 131072);
        if (threadIdx.x < 32) MISC[threadIdx.x] = 0u;
        __syncthreads();
        (void)xcd_barrier_post((unsigned*)(P.ws + WS_CTL), MISC + 8);
        if (P.ph_hi > 1000) cg::this_grid().sync();
    }
#ifndef NO_P0
    if (IN(0)) for (int rp_ = 0; rp_ < REP_P0; ++rp_) { const int lq_ = 0; PH_BEGIN(); phase0(P, lds, tid, wave, lane, G); }
#endif
    SEAM(0);
    for (int lq_ = 0; lq_ < 2; ++lq_) {
        const int pb = 1 + 9 * lq_;
#ifndef NO_NORM
        if (IN(pb + 0)) for (int rp_ = 0; rp_ < REP_NORM; ++rp_) { PH_BEGIN();
            phase_norm<3>(l == 0 ? (const void*)pin(P, 0) : (const void*)P.out, l == 0 ? 0 : 1, l == 0 ? pin(P, 2) : WSP(float, WS_HC), NROW, pin(P, 4) + l * DM, mod, 0, 1024, WSP(bf16_t, WS_U), WSP(const float, WS_PART), l == 0 ? 0 : 11, WSP(float, WS_HC), wave, lane, G); }
#endif
        SEAM(pb + 0);
#ifndef NO_WIN
        if (IN(pb + 1)) for (int rp_ = 0; rp_ < REP_WIN; ++rp_) { PH_BEGIN();
            pg8::Gemm g{WSP(bf16_t, WS_U), WSP(const bf16_t, WS_WIN) + (size_t)l * NWIN * 1024, NROW, NWIN, 1024, 1024}; pg8::StaticOrder S; S.init(NROW, NWIN, G, (int)blockIdx.x);
            EpiWin E{ws, pin(P, 11) + l * 32, pin(P, 12) + l * 32, pin(P, 9) + l * 16};
            pg8::gemm_phase<EpiWin, pg8::StaticOrder, true, true>(lds, g, S, E, wave_s);
        }
#endif
        SEAM(pb + 1);
        if (IN(pb + 4)) { PH_BEGIN();
            const int ntile = last ? 256 : 272, nskip = ntile > G ? ntile - G : 0;
#ifndef NO_MLOC
            { float* NS = WSP(float, WS_NS); float* NL = NS + 32 * NCH * 64; float* MS = NL + 32 * NCH * 64; float* ML = MS + 32 * NCH; float* BT = ML + 32 * NCH;
              const int stride = (G - nskip) * 8;
              if ((int)blockIdx.x >= nskip)
              for (int it = (G - 1 - (int)blockIdx.x) * 8 + wave; it < 32 * NCH; it += stride) mlstm_local(lds, wave, lane, it, WSP(bf16_t, WS_MKT), WSP(bf16_t, WS_MVT), WSP(float, WS_GATE), WSP(float, WS_CL), NL, ML, BT);
              xcd_arrive(WSP(unsigned, WS_CTL) + 4096, (volatile LAS unsigned*)(lds + 131072) + 8, tid); }
#endif
#ifndef NO_TILE
            { LAS float* dww = (LAS float*)(lds + 83456); const float* dw_w = pin(P, 18) + (size_t)l * 31 * 256; for (int i = tid; i < 31 * 256; i += 512) dww[i] = dw_w[i]; }
            for (int t2 = blockIdx.x; t2 < ntile * REP_TILE; t2 += G) { const int t = t2 % ntile;
                mixer_tile(lds, tid, wave, lane, t, WSP(bf16_t, WS_PC), WSP(const bf16_t, WS_POOLW) + (size_t)l * 4 * 64 * 64, pin(P, 17) + l * 256, pin(P, 19) + l * 256, pin(P, 20) + l * 256, pin(P, 21) + l * 256,
                           WSP(const bf16_t, WS_PW) + (size_t)l * 256 * 256, WSP(bf16_t, WS_Y)); }
#endif
#ifndef NO_MLOC
            xcd_wait(WSP(unsigned, WS_CTL) + 4096, (unsigned)(l + 1), tid);
#endif
#ifndef NO_SCAN
            {
                float* NS = WSP(float, WS_NS); float* NL = NS + 32 * NCH * 64; float* MS = NL + 32 * NCH * 64; float* ML = MS + 32 * NCH; float* BT = ML + 32 * NCH;
                unsigned ndone = 0;
                for (int it = blockIdx.x; it < 256; it += G) { mlstm_scan(lds, tid, it, WSP(float, WS_CL), NL, ML, BT, WSP(bf16_t, WS_CS), NS, MS); ++ndone; }
                (void)ndone; xcd_arrive(WSP(unsigned, WS_CTL) + 12288, (volatile LAS unsigned*)(lds + 131072) + 8, tid);
            }
#endif
            const float lam_init = 0.8f - 0.6f * expf(-0.3f * (float)l);
            const float* lq = pin(P, 13) + l * 64; const float* lk = pin(P, 14) + l * 64;
            const float d0 = wave_sum(lane, lane < 32 ? lq[lane] * lk[lane] : 0.f), d1 = wave_sum(lane, lane < 32 ? lq[32 + lane] * lk[32 + lane] : 0.f);
            const float lam = expf(d0) - expf(d1) + lam_init;
            const float mq = wave_max(lane, lane < 32 ? fabsf(pin(P, 11)[l * 32 + lane]) : 0.f), mk = wave_max(lane, lane < 32 ? fabsf(pin(P, 12)[l * 32 + lane]) : 0.f);
            const float negshift = -(5.656854249492381f * 1.4426950408889634f) * mq * mk;
            const int nunit = last ? 256 : 272;
#ifndef NO_ATT
            for (int rp_ = 0; rp_ < REP_ATT; ++rp_)
            for (int uidx = blockIdx.x; uidx < nunit; uidx += G) {
                int bh, qrow0, nt_;
                if (uidx < 256) { bh = uidx >> 4; qrow0 = (bh >> 2) * SEQ + (uidx & 15) * 256; nt_ = NCH; } else { bh = uidx - 256; qrow0 = NLAT + (bh >> 2) * CTXL; nt_ = 4; }
                if (negshift > -64.f) attn_unit<false>(lds, tid, wave, lane, bh >> 2, bh & 3, qrow0, nt_, lam, 0.f, 1.f - lam_init, WSP(bf16_t, WS_AQ), WSP(bf16_t, WS_AK), WSP(bf16_t, WS_AVT), pin(P, 15) + l * 64, WSP(bf16_t, WS_Y));
                else attn_unit<true>(lds, tid, wave, lane, bh >> 2, bh & 3, qrow0, nt_, lam, negshift, 1.f - lam_init, WSP(bf16_t, WS_AQ), WSP(bf16_t, WS_AK), WSP(bf16_t, WS_AVT), pin(P, 15) + l * 64, WSP(bf16_t, WS_Y));
            }
#endif
            __syncthreads();
#ifndef NO_SCAN
            xcd_wait(WSP(unsigned, WS_CTL) + 12288, (unsigned)(l + 1), tid);
#endif
#ifndef NO_MOUT
            { float* NS = WSP(float, WS_NS); float* MS = NS + 2 * 32 * NCH * 64;
            for (int rp_ = 0; rp_ < REP_MOUT; ++rp_)
            for (int it = (((int)blockIdx.x + G - nskip) % G) * 8 + wave; it < 16 * NCH * 2; it += G * 8) { if (last && ((it >> 1) % NCH) < 4) continue;
                mlstm_out(lds, wave, lane, it, WSP(bf16_t, WS_PM), WSP(bf16_t, WS_MVT), WSP(float, WS_GATE), WSP(bf16_t, WS_CS), NS, MS, pin(P, 10) + l * 64, WSP(bf16_t, WS_Y)); } }
#endif
        }
#ifndef NO_P0
        if (IN(pb + 4) && lq_ == 0) { PH_BEGIN(); __syncthreads();
            const int nbusy = G > 64 ? 32 : 0; int first_ = IT_LAYER + ((int)blockIdx.x - nbusy) * 8 + wave; asm volatile("" : "+s"(first_));
            if ((int)blockIdx.x >= nbusy) tr_range(P, ws, lds, wave, lane, first_, (G - nbusy) * 8, 2 * IT_LAYER); __syncthreads(); }
#endif
        SEAM(pb + 4);
#ifndef NO_WOUT
        if (IN(pb + 5)) { PH_BEGIN();
            { pg8::Gemm g{WSP(bf16_t, WS_Y), WSP(const bf16_t, WS_WOUT) + (size_t)l * 1024 * 1024, NLAT, 1024, 1024, 1024}; pg8::StaticOrder S; S.init(NLAT, 1024, G, (int)blockIdx.x);
              EpiRes E{l == 0 ? (const void*)pin(P, 0) : (const void*)P.out, l == 0 ? (void*)P.out : (void*)(ws + WS_HB2), mod + 2048, l == 0 ? 0 : 1, 1};
              pg8::gemm_phase<EpiRes, pg8::StaticOrder, true, true>(lds, g, S, E, wave_s); }
#ifndef NO_CTXW
            if (!last) {
                pg8::Gemm gc{WSP(bf16_t, WS_Y) + (size_t)NLAT * 1024, WSP(const bf16_t, WS_WOUT) + (size_t)l * 1024 * 1024, NCTX, 1024, 256, 1024}; pg8::SplitOrder Sc; Sc.init(NCTX, 1024, 4, 256, G, (int)blockIdx.x);
                EpiPart Ec{WSP(float, WS_PART), mod + 2048 + 4 * 6144};
                pg8::gemm_phase<EpiPart, pg8::SplitOrder, true, true, true>(lds, gc, Sc, Ec, wave_s); }
#endif
        }
#endif
        SEAM(pb + 5);
#ifndef NO_NORM
        if (IN(pb + 6)) for (int rp_ = 0; rp_ < REP_NORM; ++rp_) { PH_BEGIN();
            if (last) phase_norm<4>((const void*)(ws + WS_HB2), 1, WSP(float, WS_HC), NLAT, pin(P, 5) + l * DM, mod, 3072, 4096, WSP(bf16_t, WS_U), WSP(const float, WS_PART), 0, WSP(float, WS_HC), wave, lane, G);
            else phase_norm<3>((const void*)P.out, 1, pin(P, 2), NROW, pin(P, 5) + l * DM, mod, 3072, 4096, WSP(bf16_t, WS_U), WSP(const float, WS_PART), 4, WSP(float, WS_HC), wave, lane, G); }
#endif
        SEAM(pb + 6);
#ifndef NO_FIN
        if (IN(pb + 7)) for (int rp_ = 0; rp_ < REP_FIN; ++rp_) { PH_BEGIN();
            const int Mrows = last ? NLAT : NROW;
            pg8::Gemm g{WSP(bf16_t, WS_U), WSP(const bf16_t, WS_FIN) + (size_t)l * 2 * DFF * 1024, Mrows, 2 * DFF, 1024, 1024}; pg8::StaticOrder S; S.init(Mrows, 2 * DFF, G, (int)blockIdx.x);
            EpiSwiglu E{WSP(bf16_t, WS_HF)};
            pg8::gemm_phase<EpiSwiglu, pg8::StaticOrder, true, true>(lds, g, S, E, wave_s);
        }
#endif
        SEAM(pb + 7);
#ifndef NO_FOUT
        if (IN(pb + 8)) { PH_BEGIN();
            { pg8::Gemm g{WSP(bf16_t, WS_HF), WSP(const bf16_t, WS_FOUT) + (size_t)l * 1024 * DFF, NLAT, 1024, DFF, DFF}; pg8::StaticOrder S; S.init(NLAT, 1024, G, (int)blockIdx.x);
              EpiRes E{l == 0 ? (const void*)P.out : (const void*)(ws + WS_HB2), (void*)P.out, mod + 5120, 1, l == 0 ? 1 : 0};
              pg8::gemm_phase<EpiRes, pg8::StaticOrder, true, true>(lds, g, S, E, wave_s); }
#ifndef NO_CTXF
            if (!last) {
                pg8::Gemm gc{WSP(bf16_t, WS_HF) + (size_t)NLAT * DFF, WSP(const bf16_t, WS_FOUT) + (size_t)l * 1024 * DFF, NCTX, 1024, 256, DFF}; pg8::SplitOrder Sc; Sc.init(NCTX, 1024, 11, 256, G, (int)blockIdx.x);
                EpiPart Ec{WSP(float, WS_PART), mod + 5120 + 4 * 6144};
                pg8::gemm_phase<EpiPart, pg8::SplitOrder, true, true, true>(lds, gc, Sc, Ec, wave_s); }
#endif
        }
#endif
        if (lq_ == 0) SEAM(pb + 8);
    }
#undef IN
#undef SEAM
}

constexpr int NPHASE = 19;
extern "C" void kernel_launch(void* const* d_in, const int* in_sizes, int n_in, void* d_out, int out_size, void* d_ws, size_t ws_size, hipStream_t stream) {
    static int grid = 0;
    if (grid == 0) {
        if (n_in != 26 || out_size != NLAT * DM || ws_size < WS_END) { fprintf(stderr, "kernel_launch: unexpected shapes (n_in %d out %d ws %zu)\n", n_in, out_size, ws_size); grid = -1; return; }
        int dev = 0, cus = 0, per_cu = 0;
        hipGetDevice(&dev); hipDeviceGetAttribute(&cus, hipDeviceAttributeMultiprocessorCount, dev);
        hipFuncSetAttribute((const void*)mega, hipFuncAttributeMaxDynamicSharedMemorySize, LDS_BYTES);
        hipOccupancyMaxActiveBlocksPerMultiprocessor(&per_cu, (const void*)mega, 512, LDS_BYTES);
        if (per_cu < 1) per_cu = 1;
        grid = cus * per_cu;
        (void)hipGetLastError();
    }
    if (grid < 0) return;
    hipMemsetAsync((unsigned char*)d_ws + WS_CTL, 0, CTL_BYTES, stream);
    Params p{};
    for (int i = 0; i < 26; ++i) p.in[i] = (const float*)d_in[i];
    p.out = (float*)d_out; p.ws = (unsigned char*)d_ws;
#if MK_COOP
    p.ph_lo = 0; p.ph_hi = NPHASE;
    void* args[] = {&p};
    hipError_t e = hipLaunchCooperativeKernel((const void*)mega, dim3(grid), dim3(512), args, LDS_BYTES, stream);
    if (e != hipSuccess) fprintf(stderr, "cooperative launch failed: %s (grid %d)\n", hipGetErrorString(e), grid);
#else
    for (int ph = 0; ph < NPHASE; ++ph) { p.ph_lo = ph; p.ph_hi = ph + 1; hipLaunchKernelGGL(mega, dim3(grid), dim3(512), LDS_BYTES, stream, p); }
#endif
}
```
